# Optimizing an MI355X kernel written in HIP

```python
import math, functools
import jax, jax.numpy as jnp
from jax import lax
import numpy as np

D_MODEL = 1024
BATCH = 4
SEQ = 4096
DEPTH = 2
DEC_BATCH = 32
DEC_SEQ = 16
PAST_LEN = 2048

CHUNK = 64
Q_BLOCK = 128
N_EVEN = (DEPTH + 1) // 2
N_ODD = DEPTH // 2
ALPHA = (2 * DEPTH) ** 0.25
BETA = (8 * DEPTH) ** -0.25
EPS = 1e-5
NEG_INF = -1e30
MLA_HEADS = 8
Q_LORA = 256
KV_LORA = 128
MLA_NOPE_DIM = 64
MLA_ROPE_DIM = 32
MLA_QK_DIM = MLA_NOPE_DIM + MLA_ROPE_DIM
MLA_V_DIM = 64
MLA_ROPE_THETA = 10000.0
MLA_W = MLA_HEADS * MLA_V_DIM
DIFF_HEADS = 4
DIFF_HD = 64
DIFF_ROT = DIFF_HD // 4
ROPE_THETA = 500000.0
DIFF_W = DIFF_HEADS * 2 * DIFF_HD
SB_HEADS = 16
SB_HD = 64
SB_W = SB_HEADS * SB_HD
EVEN_SECTIONS = (Q_LORA, KV_LORA, MLA_ROPE_DIM, MLA_W, DIFF_W, DIFF_W, DIFF_W, DIFF_W)
EVEN_IN = Q_LORA + KV_LORA + MLA_ROPE_DIM + MLA_W + 4 * DIFF_W
EVEN_OUT = MLA_W + DIFF_W
DV_START = Q_LORA + KV_LORA + MLA_ROPE_DIM + MLA_W + 2 * DIFF_W

kernel_name = 'hybrid_stream_mla_diff_stickbreak_step'


def _layernorm(x, g, b):
    xf = x.astype(jnp.float32)
    mu = jnp.mean(xf, axis=-1, keepdims=True)
    xc = xf - mu
    var = jnp.mean(xc * xc, axis=-1, keepdims=True)
    return (xc * lax.rsqrt(var + EPS) * g.astype(jnp.float32) + b.astype(jnp.float32)).astype(x.dtype)


def _rmsnorm(x, g):
    xf = x.astype(jnp.float32)
    ms = jnp.mean(xf * xf, axis=-1, keepdims=True)
    return (xf * lax.rsqrt(ms + EPS) * g.astype(jnp.float32)).astype(x.dtype)


def _rope(x, pos, rot_dim, theta):
    half = rot_dim // 2
    inv = jnp.exp(-math.log(theta) * jnp.arange(half, dtype=jnp.float32) * (2.0 / rot_dim))
    ang = pos.astype(jnp.float32)[:, None] * inv[None, :]
    shape = (pos.shape[0],) + (1,) * (x.ndim - 3) + (half,)
    cos = jnp.cos(ang).reshape(shape).astype(x.dtype)
    sin = jnp.sin(ang).reshape(shape).astype(x.dtype)
    x1, x2, rest = x[..., :half], x[..., half:rot_dim], x[..., rot_dim:]
    return jnp.concatenate([x1 * cos - x2 * sin, x1 * sin + x2 * cos, rest], axis=-1)


def _split_cols(h, sizes):
    offs = np.cumsum(np.array(sizes))[:-1].tolist()
    return jnp.split(h, offs, axis=-1)


def _chunk_mask(qpos, kpos):
    return (kpos[None, :] // CHUNK) <= (qpos[:, None] // CHUNK)


def _mla_core(q_abs, q_rope, ckv, krope, qpos, kpos):
    s = (jnp.einsum('bqhc,bkc->bhqk', q_abs, ckv) + jnp.einsum('bqhr,bkr->bhqk', q_rope, krope)).astype(jnp.float32)
    s = jnp.where(_chunk_mask(qpos, kpos), s * (MLA_QK_DIM ** -0.5), NEG_INF)
    p = jax.nn.softmax(s, axis=-1).astype(ckv.dtype)
    return jnp.einsum('bhqk,bkc->bqhc', p, ckv)


def _diff_core(q, k, v, qpos, kpos, lam):
    s = jnp.einsum('bqhid,bkhid->bhiqk', q, k).astype(jnp.float32) * (DIFF_HD ** -0.5)
    s = jnp.where(_chunk_mask(qpos, kpos), s, NEG_INF)
    p = jax.nn.softmax(s, axis=-1)
    a = (p[:, :, 0] - lam * p[:, :, 1]).astype(v.dtype)
    return jnp.einsum('bhqk,bkhe->bqhe', a, v)


def _sb_core(q, k, v, qpos, kpos):
    z = jnp.einsum('bqhd,bkhd->bhqk', q, k).astype(jnp.float32) * (SB_HD ** -0.5)
    valid = kpos[None, :] < qpos[:, None]
    log_beta = jax.nn.log_sigmoid(z)
    log_rem = jnp.where(valid, jax.nn.log_sigmoid(-z), 0.0)
    later = lax.cumsum(log_rem, axis=3, reverse=True) - log_rem
    a = jnp.where(valid, jnp.exp(log_beta + later), 0.0).astype(v.dtype)
    return jnp.einsum('bhqk,bkhd->bqhd', a, v)


def _sweep_queries(core, q_args, kv_args, seq_len):
    nb = seq_len // Q_BLOCK
    kpos = jnp.arange(seq_len, dtype=jnp.int32)

    def to_blocks(a):
        return jnp.swapaxes(a.reshape((a.shape[0], nb, Q_BLOCK) + a.shape[2:]), 0, 1)

    def one_block(args):
        i, qb = args
        qpos = i * Q_BLOCK + jnp.arange(Q_BLOCK, dtype=jnp.int32)
        return core(*qb, *kv_args, qpos, kpos)

    out = lax.map(one_block, (jnp.arange(nb, dtype=jnp.int32), tuple(to_blocks(a) for a in q_args)))
    out = jnp.swapaxes(out, 0, 1)
    return out.reshape((out.shape[0], seq_len) + out.shape[3:])


def _even_layer(x, pos, caches, prm, lam_init):
    (w_in, q_g, w_uq, kv_g, w_uk, w_uv, lam_q, lam_k, subln_g, w_out, ln_g, ln_b) = prm
    b, s, _ = x.shape
    h = x @ w_in
    q_lat, ckv, krope, g_mla, dq, dk, dv, g_diff = _split_cols(h, EVEN_SECTIONS)
    q = (_rmsnorm(q_lat, q_g) @ w_uq).reshape(b, s, MLA_HEADS, MLA_QK_DIM)
    q_rope = _rope(q[..., MLA_NOPE_DIM:], pos, MLA_ROPE_DIM, MLA_ROPE_THETA)
    q_abs = jnp.einsum('bshn,chn->bshc', q[..., :MLA_NOPE_DIM], w_uk)
    ckv = _rmsnorm(ckv, kv_g)
    krope = _rope(krope, pos, MLA_ROPE_DIM, MLA_ROPE_THETA)
    dq = _rope(dq.reshape(b, s, DIFF_HEADS, 2, DIFF_HD), pos, DIFF_ROT, ROPE_THETA)
    dk = _rope(dk.reshape(b, s, DIFF_HEADS, 2, DIFF_HD), pos, DIFF_ROT, ROPE_THETA)
    dv = dv.reshape(b, s, DIFF_HEADS, 2 * DIFF_HD)
    lq = lam_q.astype(jnp.float32)
    lk = lam_k.astype(jnp.float32)
    lam = jnp.exp(jnp.sum(lq[0] * lk[0])) - jnp.exp(jnp.sum(lq[1] * lk[1])) + lam_init
    diff_core = functools.partial(_diff_core, lam=lam)
    if caches is None:
        o_lat = _sweep_queries(_mla_core, (q_abs, q_rope), (ckv, krope), s)
        o_diff = _sweep_queries(diff_core, (dq,), (dk, dv), s)
    else:
        ckv_c, krope_c, dk_c, dv_c = caches
        kpos = jnp.arange(ckv_c.shape[1] + s, dtype=jnp.int32)
        o_lat = _mla_core(q_abs, q_rope, jnp.concatenate([ckv_c, ckv], axis=1),
                          jnp.concatenate([krope_c, krope], axis=1), pos, kpos)
        o_diff = diff_core(dq, jnp.concatenate([dk_c, dk], axis=1), jnp.concatenate([dv_c, dv], axis=1), pos, kpos)
    o_mla = jnp.einsum('bshc,chv->bshv', o_lat, w_uv).reshape(b, s, MLA_W)
    o_diff = (_rmsnorm(o_diff, subln_g) * (1.0 - lam_init)).reshape(b, s, DIFF_W)
    o = jnp.concatenate([o_mla * jax.nn.silu(g_mla), o_diff * jax.nn.silu(g_diff)], axis=-1) @ w_out
    y = _layernorm(ALPHA * x + o, ln_g, ln_b)
    return y, (ckv, krope, dk, dv)


def _odd_layer(x, pos, caches, prm):
    w_in, w_out, ln_g, ln_b = prm
    b, s, _ = x.shape
    q, k, v, g = _split_cols(x @ w_in, (SB_W, SB_W, SB_W, SB_W))
    q = q.reshape(b, s, SB_HEADS, SB_HD)
    k = k.reshape(b, s, SB_HEADS, SB_HD)
    v = v.reshape(b, s, SB_HEADS, SB_HD)
    if caches is None:
        o = _sweep_queries(_sb_core, (q,), (k, v), s)
    else:
        k_c, v_c = caches
        kpos = jnp.arange(k_c.shape[1] + s, dtype=jnp.int32)
        o = _sb_core(q, jnp.concatenate([k_c, k], axis=1), jnp.concatenate([v_c, v], axis=1), pos, kpos)
    o = (o.reshape(b, s, SB_W) * jax.nn.silu(g)) @ w_out
    y = _layernorm(ALPHA * x + o, ln_g, ln_b)
    return y, (k, v)


def setup_inputs(seed: int = 0) -> dict:
    key = jax.random.key(seed)
    ks = jax.random.split(key, 24)

    def nrm(k, shape, scale):
        return jax.random.normal(k, shape, jnp.float32) * scale

    w_in_even = nrm(ks[8], (N_EVEN, D_MODEL, EVEN_IN), D_MODEL ** -0.5)
    w_in_even = w_in_even.at[:, :, DV_START:DV_START + DIFF_W].multiply(BETA)
    w_in_odd = nrm(ks[19], (N_ODD, D_MODEL, 4 * SB_W), D_MODEL ** -0.5)
    w_in_odd = w_in_odd.at[:, :, 2 * SB_W:3 * SB_W].multiply(BETA)
    return {
        'x_prompt': nrm(ks[0], (BATCH, SEQ, D_MODEL), 1.0),
        'x_sample': nrm(ks[1], (DEC_BATCH, DEC_SEQ, D_MODEL), 1.0),
        'cache_mla_ckv': nrm(ks[2], (N_EVEN, DEC_BATCH, PAST_LEN, KV_LORA), 1.0),
        'cache_mla_krope': nrm(ks[3], (N_EVEN, DEC_BATCH, PAST_LEN, MLA_ROPE_DIM), 1.0),
        'cache_diff_k': nrm(ks[4], (N_EVEN, DEC_BATCH, PAST_LEN, DIFF_HEADS, 2, DIFF_HD), 1.0),
        'cache_diff_v': nrm(ks[5], (N_EVEN, DEC_BATCH, PAST_LEN, DIFF_HEADS, 2 * DIFF_HD), BETA),
        'cache_sb_k': nrm(ks[6], (N_ODD, DEC_BATCH, PAST_LEN, SB_HEADS, SB_HD), 1.0),
        'cache_sb_v': nrm(ks[7], (N_ODD, DEC_BATCH, PAST_LEN, SB_HEADS, SB_HD), BETA),
        'w_in_even': w_in_even,
        'q_norm_g': 1.0 + nrm(ks[9], (N_EVEN, Q_LORA), 0.02),
        'w_uq': nrm(ks[10], (N_EVEN, Q_LORA, MLA_HEADS * MLA_QK_DIM), Q_LORA ** -0.5),
        'kv_norm_g': 1.0 + nrm(ks[11], (N_EVEN, KV_LORA), 0.02),
        'w_uk': nrm(ks[12], (N_EVEN, KV_LORA, MLA_HEADS, MLA_NOPE_DIM), KV_LORA ** -0.5),
        'w_uv': nrm(ks[13], (N_EVEN, KV_LORA, MLA_HEADS, MLA_V_DIM), KV_LORA ** -0.5 * BETA),
        'diff_lambda_q': nrm(ks[14], (N_EVEN, 2, DIFF_HD), 0.1),
        'diff_lambda_k': nrm(ks[15], (N_EVEN, 2, DIFF_HD), 0.1),
        'diff_subln_g': 1.0 + nrm(ks[16], (N_EVEN, 2 * DIFF_HD), 0.02),
        'w_out_even': nrm(ks[17], (N_EVEN, EVEN_OUT, D_MODEL), EVEN_OUT ** -0.5 * BETA),
        'ln_even_g': 1.0 + nrm(ks[18], (N_EVEN, D_MODEL), 0.02),
        'ln_even_b': nrm(ks[20], (N_EVEN, D_MODEL), 0.02),
        'w_in_odd': w_in_odd,
        'w_out_odd': nrm(ks[21], (N_ODD, SB_W, D_MODEL), SB_W ** -0.5 * BETA),
        'ln_odd_g': 1.0 + nrm(ks[22], (N_ODD, D_MODEL), 0.02),
        'ln_odd_b': nrm(ks[23], (N_ODD, D_MODEL), 0.02),
    }


def reference(x_prompt, x_sample, cache_mla_ckv, cache_mla_krope, cache_diff_k, cache_diff_v, cache_sb_k, cache_sb_v,
              w_in_even, q_norm_g, w_uq, kv_norm_g, w_uk, w_uv, diff_lambda_q, diff_lambda_k, diff_subln_g,
              w_out_even, ln_even_g, ln_even_b, w_in_odd, w_out_odd, ln_odd_g, ln_odd_b):
    pos_p = jnp.arange(x_prompt.shape[1], dtype=jnp.int32)
    pos_s = cache_sb_k.shape[2] + jnp.arange(x_sample.shape[1], dtype=jnp.int32)
    yp, ys = x_prompt, x_sample
    even_p, even_s, odd_p, odd_s = [], [], [], []
    for layer in range(DEPTH):
        i = layer // 2
        if layer % 2 == 0:
            prm = (w_in_even[i], q_norm_g[i], w_uq[i], kv_norm_g[i], w_uk[i], w_uv[i], diff_lambda_q[i],
                   diff_lambda_k[i], diff_subln_g[i], w_out_even[i], ln_even_g[i], ln_even_b[i])
            lam_init = 0.8 - 0.6 * math.exp(-0.3 * layer)
            yp, st_p = _even_layer(yp, pos_p, None, prm, lam_init)
            ys, st_s = _even_layer(ys, pos_s, (cache_mla_ckv[i], cache_mla_krope[i], cache_diff_k[i], cache_diff_v[i]),
                                   prm, lam_init)
            even_p.append(st_p)
            even_s.append(st_s)
        else:
            prm = (w_in_odd[i], w_out_odd[i], ln_odd_g[i], ln_odd_b[i])
            yp, st_p = _odd_layer(yp, pos_p, None, prm)
            ys, st_s = _odd_layer(ys, pos_s, (cache_sb_k[i], cache_sb_v[i]), prm)
            odd_p.append(st_p)
            odd_s.append(st_s)
    return (yp, ys,
            jnp.stack([t[0] for t in even_p]), jnp.stack([t[1] for t in even_p]),
            jnp.stack([t[2] for t in even_p]), jnp.stack([t[3] for t in even_p]),
            jnp.stack([t[0] for t in odd_p]), jnp.stack([t[1] for t in odd_p]),
            jnp.stack([t[0] for t in even_s]), jnp.stack([t[1] for t in even_s]),
            jnp.stack([t[2] for t in even_s]), jnp.stack([t[3] for t in even_s]),
            jnp.stack([t[0] for t in odd_s]), jnp.stack([t[1] for t in odd_s]))
```

```cpp
#include <hip/hip_runtime.h>
#include <hip/hip_cooperative_groups.h>
#include <stdint.h>
#include <stdio.h>
#include <string.h>
namespace cg = cooperative_groups;

typedef unsigned short u16;
using bf16x8 = __attribute__((ext_vector_type(8))) short;
using s16x4  = __attribute__((ext_vector_type(4))) short;
using f32x16 = __attribute__((ext_vector_type(16))) float;
using u32x4  = __attribute__((ext_vector_type(4))) unsigned;
using f32x4  = __attribute__((ext_vector_type(4))) float;
typedef __attribute__((ext_vector_type(2))) __bf16 bf2_t;
#define DI __device__ __forceinline__
#define LAS __attribute__((address_space(3)))
#define MFMA(a, b, c) __builtin_amdgcn_mfma_f32_32x32x16_bf16((a), (b), (c), 0, 0, 0)

constexpr int TP = 16384;
constexpr int TS = 512;
constexpr int T  = TP + TS;
constexpr int MT = T / 128;
constexpr float EPS = 1e-5f;
constexpr float ALPHA = 1.4142135623730951f;
constexpr float LOG2E = 1.4426950408889634f;
constexpr float QS_MLA = 0.10206207261596577f * LOG2E;
constexpr float QS_64  = 0.125f * LOG2E;
constexpr float LAM_INIT = 0.2f;

constexpr size_t OFF_YP = 0, OFF_YS = 16777216, OFF_CKV_P = 17301504, OFF_KR_P = 19398656, OFF_DK_P = 19922944,
                 OFF_DV_P = 28311552, OFF_SK_P = 36700160, OFF_SV_P = 53477376, OFF_CKV_S = 70254592, OFF_KR_S = 70320128,
                 OFF_DK_S = 70336512, OFF_DV_S = 70598656, OFF_SK_S = 70860800, OFF_SV_S = 71385088;

constexpr int SMEM_MAIN = 75776;
constexpr int SMEM_TOTAL = SMEM_MAIN + 64;

#define BAR_BYTES   32768
constexpr size_t al256(size_t x) { return (x + 255) & ~(size_t)255; }
constexpr size_t WS_bar = 0;
constexpr size_t WS_xb = WS_bar + al256(BAR_BYTES);
constexpr size_t WS_Wt_in_e = WS_xb + al256((size_t)T*1024*2);
constexpr size_t WS_Wc = WS_Wt_in_e + al256((size_t)3072*1024*2);
constexpr size_t WS_Wt_uv = WS_Wc + al256((size_t)1280*256*2);
constexpr size_t WS_Wt_out_e = WS_Wt_uv + al256((size_t)512*128*2);
constexpr size_t WS_Wt_in_o = WS_Wt_out_e + al256((size_t)1024*1024*2);
constexpr size_t WS_Wt_out_o = WS_Wt_in_o + al256((size_t)4096*1024*2);
constexpr size_t WS_qlat = WS_Wt_out_o + al256((size_t)1024*1024*2);
constexpr size_t WS_Kmla = WS_qlat + al256((size_t)T*256*2);
constexpr size_t WS_gm = WS_Kmla + al256((size_t)T*160*2);
constexpr size_t WS_dqb = WS_gm + al256((size_t)T*512*2);
constexpr size_t WS_dkb = WS_dqb + al256((size_t)T*512*2);
constexpr size_t WS_dvb = WS_dkb + al256((size_t)T*512*2);
constexpr size_t WS_gd = WS_dvb + al256((size_t)T*512*2);
constexpr size_t WS_Qmla = WS_gd + al256((size_t)T*512*2);
constexpr size_t WS_A2 = WS_Qmla + al256((size_t)T*1280*2);
constexpr size_t WS_y0b = WS_A2 + al256((size_t)T*1024*2);
constexpr size_t WS_sqb = WS_y0b + al256((size_t)T*1024*2);
constexpr size_t WS_skb = WS_sqb + al256((size_t)T*1024*2);
constexpr size_t WS_svb = WS_skb + al256((size_t)T*1024*2);
constexpr size_t WS_sgb = WS_svb + al256((size_t)T*1024*2);
constexpr size_t WS_ssq = WS_sgb + al256((size_t)T*1024*2);
constexpr size_t WS_pre = WS_ssq + al256((size_t)T*2*4);
constexpr size_t WS_y0f = WS_pre + al256((size_t)T*1024*4);
constexpr size_t WS_ropeC = WS_y0f + al256((size_t)T*1024*4);
constexpr size_t WS_ropeS = WS_ropeC + al256((size_t)4096*24*4);
constexpr size_t WS_lam = WS_ropeS + al256((size_t)4096*24*4);
constexpr size_t WS_END = WS_lam + al256(256);
struct Params {
  const float *x_prompt, *x_sample, *c_ckv, *c_krope, *c_dk, *c_dv, *c_sk, *c_sv;
  const float *w_in_even, *q_g, *w_uq, *kv_g, *w_uk, *w_uv, *lam_q, *lam_k, *subln_g, *w_out_even, *ln_e_g, *ln_e_b;
  const float *w_in_odd, *w_out_odd, *ln_o_g, *ln_o_b;
  float* out;
  char* ws;
  int use_cg; int pad_;
  DI unsigned* bar() const { return (unsigned*)(ws + WS_bar); }
  DI u16* xb() const { return (u16*)(ws + WS_xb); }
  DI u16* Wt_in_e() const { return (u16*)(ws + WS_Wt_in_e); }
  DI u16* Wc() const { return (u16*)(ws + WS_Wc); }
  DI u16* Wt_uv() const { return (u16*)(ws + WS_Wt_uv); }
  DI u16* Wt_out_e() const { return (u16*)(ws + WS_Wt_out_e); }
  DI u16* Wt_in_o() const { return (u16*)(ws + WS_Wt_in_o); }
  DI u16* Wt_out_o() const { return (u16*)(ws + WS_Wt_out_o); }
  DI u16* qlat() const { return (u16*)(ws + WS_qlat); }
  DI u16* Kmla() const { return (u16*)(ws + WS_Kmla); }
  DI u16* gm() const { return (u16*)(ws + WS_gm); }
  DI u16* dqb() const { return (u16*)(ws + WS_dqb); }
  DI u16* dkb() const { return (u16*)(ws + WS_dkb); }
  DI u16* dvb() const { return (u16*)(ws + WS_dvb); }
  DI u16* gd() const { return (u16*)(ws + WS_gd); }
  DI u16* Qmla() const { return (u16*)(ws + WS_Qmla); }
  DI u16* A2() const { return (u16*)(ws + WS_A2); }
  DI u16* y0b() const { return (u16*)(ws + WS_y0b); }
  DI u16* sqb() const { return (u16*)(ws + WS_sqb); }
  DI u16* skb() const { return (u16*)(ws + WS_skb); }
  DI u16* svb() const { return (u16*)(ws + WS_svb); }
  DI u16* sgb() const { return (u16*)(ws + WS_sgb); }
  DI float* ssq() const { return (float*)(ws + WS_ssq); }
  DI float* pre() const { return (float*)(ws + WS_pre); }
  DI float* y0f() const { return (float*)(ws + WS_y0f); }
  DI float* ropeC() const { return (float*)(ws + WS_ropeC); }
  DI float* ropeS() const { return (float*)(ws + WS_ropeS); }
  DI float* lam() const { return (float*)(ws + WS_lam); }
};

DI unsigned pk2(float a, float b) { bf2_t v; v[0] = (__bf16)a; v[1] = (__bf16)b; return __builtin_bit_cast(unsigned, v); }
DI float bf2f(u16 v) { return __uint_as_float(((unsigned)v) << 16); }
DI float bflo(unsigned v) { return __uint_as_float(v << 16); }
DI float bfhi(unsigned v) { return __uint_as_float(v & 0xffff0000u); }
DI bf16x8 pack8(float a0, float a1, float a2, float a3, float a4, float a5, float a6, float a7) {
  u32x4 p; p[0] = pk2(a0, a1); p[1] = pk2(a2, a3); p[2] = pk2(a4, a5); p[3] = pk2(a6, a7);
  return __builtin_bit_cast(bf16x8, p);
}
DI uint2 pack4(float a0, float a1, float a2, float a3) { return make_uint2(pk2(a0, a1), pk2(a2, a3)); }
DI float x32_max(float x) { auto r = __builtin_amdgcn_permlane32_swap(__float_as_uint(x), __float_as_uint(x), false, false); return fmaxf(__uint_as_float(r[0]), __uint_as_float(r[1])); }
DI float x32_sum(float x) { auto r = __builtin_amdgcn_permlane32_swap(__float_as_uint(x), __float_as_uint(x), false, false); return __uint_as_float(r[0]) + __uint_as_float(r[1]); }
DI float x32_other(float x, int h) { auto r = __builtin_amdgcn_permlane32_swap(__float_as_uint(x), __float_as_uint(x), false, false); return __uint_as_float(h ? r[0] : r[1]); }
DI int otid() { int t = threadIdx.x; asm volatile("" : "+v"(t)); return t; }
DI float silu(float x) { return x * __builtin_amdgcn_rcpf(1.f + __expf(-x)); }
DI int crow(int reg, int h) { return (reg & 3) + 8 * (reg >> 2) + 4 * h; }
DI float ex2(float x) { return __builtin_amdgcn_exp2f(x); }
DI float lg2(float x) { return __builtin_amdgcn_logf(x); }

#define XB_TMO      128
#define XB_XCNT(j)  (256  + 64 * (j))
#define XB_XSUB(j)  (1280 + 64 * (j))
#define XB_XGEN(j)  (2304 + 64 * (j))
#define XB_TOP      3328
#define XB_TOPGEN   3392
#define XCD_BAR_WORDS 3456
#define XB_CTR0     3520
#define XB_CTR1     3584
#define XB_CTR2     3648
#define XB_CTR3     3712
#define XB_XQ(j)    (4096 + 64 * (j))
#define XB_XQ2(j)   (4608 + 64 * (j))
#ifndef REP
#define REP 0
#endif
#define XB_SPIN_CAP (1u << 24)
DI unsigned xb_ld(unsigned* p)              { return __hip_atomic_load(p, __ATOMIC_RELAXED, __HIP_MEMORY_SCOPE_AGENT); }
DI unsigned xb_add(unsigned* p, unsigned v) { return __hip_atomic_fetch_add(p, v, __ATOMIC_RELAXED, __HIP_MEMORY_SCOPE_AGENT); }
DI unsigned xb_xcc_id() { return (unsigned)__builtin_amdgcn_s_getreg((3 << 11) | 20) & 0xFu; }
#define XB_SPIN(cond, bar) do { unsigned _sp = 0; while (cond) { __builtin_amdgcn_s_sleep(1); \
    if ((++_sp & 255u) == 0u) { if (xb_ld(&(bar)[XB_TMO])) break; if (_sp > XB_SPIN_CAP) { atomicAdd(&(bar)[XB_TMO], 1u); break; } } } } while (0)
struct XcdBarrier { unsigned* bar; unsigned x; volatile LAS unsigned* st; };
DI XcdBarrier xcd_barrier_post(unsigned* bar, volatile LAS unsigned* st) {
  XcdBarrier b; b.bar = bar; b.x = xb_xcc_id(); b.st = st;
  if (threadIdx.x == 0) (void)xb_add(&bar[XB_XCNT(b.x)], 1u);
  return b;
}
DI void xcd_barrier_complete(unsigned* bar, unsigned x, unsigned& nloc, unsigned& nx) {
  const unsigned G = gridDim.x * gridDim.y * gridDim.z;
  unsigned sum, cnt, mine, sp = 0u;
  for (;;) {
    sum = 0u; cnt = 0u; mine = 0u;
#pragma unroll
    for (unsigned j = 0; j < 16; ++j) { const unsigned c = xb_ld(&bar[XB_XCNT(j)]); sum += c; cnt += (c > 0u) ? 1u : 0u; mine = (j == x) ? c : mine; }
    if (sum == G) break;
    __builtin_amdgcn_s_sleep(1);
    if ((++sp & 255u) == 0u) { if (xb_ld(&bar[XB_TMO])) break; if (sp > XB_SPIN_CAP) { atomicAdd(&bar[XB_TMO], 1u); break; } }
  }
  nloc = mine > 0u ? mine : 1u; nx = cnt > 0u ? cnt : 1u;
}
DI void xcd_barrier(const XcdBarrier& b) {
  asm volatile("s_waitcnt vmcnt(0)" ::: "memory");
  __syncthreads();
  if (threadIdx.x == 0) {
    unsigned* bar = b.bar;
    __builtin_amdgcn_s_waitcnt(0);
    unsigned nloc = b.st[0], nx = b.st[1];
    if (nloc == 0u) { xcd_barrier_complete(bar, b.x, nloc, nx); b.st[0] = nloc; b.st[1] = nx; }
    const unsigned old = xb_add(&bar[XB_XSUB(b.x)], 1u);
    const unsigned gen = old / nloc;
    if (old + 1u == (gen + 1u) * nloc) {
      __builtin_amdgcn_fence(__ATOMIC_RELEASE, "agent");
      asm volatile("s_waitcnt vmcnt(0)" ::: "memory");
      const unsigned og = xb_add(&bar[XB_TOP], 1u);
      const unsigned tg = og / nx;
      if (og + 1u == (tg + 1u) * nx) xb_add(&bar[XB_TOPGEN], 1u);
      else XB_SPIN(xb_ld(&bar[XB_TOPGEN]) == tg, bar);
      __builtin_amdgcn_fence(__ATOMIC_ACQUIRE, "agent");
      xb_add(&bar[XB_XGEN(b.x)], 1u);
      asm volatile("s_waitcnt vmcnt(0)" ::: "memory");
    } else {
      XB_SPIN(xb_ld(&bar[XB_XGEN(b.x)]) == gen, bar);
      __builtin_amdgcn_fence(__ATOMIC_ACQUIRE, "agent");
      asm volatile("s_waitcnt vmcnt(0)" ::: "memory");
    }
  }
  __syncthreads();
}

constexpr int CS_LD = 132;
template <int K, int BM = 128>
DI void gemm_tile(const u16* __restrict__ A, int lda, const u16* __restrict__ Bt, int ldb, int m0, int n0, char* smem) {
  const int tid = otid(), lane = tid & 63, w = tid >> 6, r = lane & 31, h = lane >> 5;
  const int wm = w >> 1, wn = w & 1;
  constexpr int IM = BM / 64;
  constexpr int NA = BM / 32;
  f32x16 acc[IM][2];
#pragma unroll
  for (int i = 0; i < IM; ++i)
#pragma unroll
    for (int j = 0; j < 2; ++j)
#pragma unroll
      for (int e = 0; e < 16; ++e) acc[i][j][e] = 0.f;
  constexpr int NK = K / 64;
  constexpr int OPB = 128 * 128;
  constexpr int BUFB = 2 * OPB;
  const int lrow = tid >> 3, cpos = tid & 7;
  const u16* ap[4]; const u16* bp[4];
#pragma unroll
  for (int i = 0; i < 4; ++i) {
    const int row = lrow + 32 * i;
    const int sc = cpos ^ ((row >> 1) & 7);
    ap[i] = A + (size_t)(m0 + (i < NA ? row : 0)) * lda + sc * 8;
    bp[i] = Bt + (size_t)(n0 + row) * ldb + sc * 8;
  }
  char* const ldst = smem + tid * 16;
  __syncthreads();
#pragma unroll
  for (int i = 0; i < 4; ++i) {
    if (i < NA) __builtin_amdgcn_global_load_lds((const unsigned*)(ap[i]), (unsigned*)(ldst + i * 4096), 16, 0, 0);
    __builtin_amdgcn_global_load_lds((const unsigned*)(bp[i]), (unsigned*)(ldst + OPB + i * 4096), 16, 0, 0);
  }
  int aoff[2], boff[2], aswz[2], bswz[2];
#pragma unroll
  for (int i = 0; i < 2; ++i) {
    const int ra_ = wm * (BM / 2) + (i < IM ? i : 0) * 32 + r, rb_ = wn * 64 + i * 32 + r;
    aoff[i] = ra_ * 128; aswz[i] = (ra_ >> 1) & 7;
    boff[i] = rb_ * 128; bswz[i] = (rb_ >> 1) & 7;
  }
  for (int kt = 0; kt < NK; ++kt) {
    asm volatile("s_waitcnt vmcnt(0)" ::: "memory");
    __syncthreads();
    const int cur = (kt & 1) * BUFB, nxt = BUFB - cur;
    if (kt + 1 < NK) {
#pragma unroll
      for (int i = 0; i < 4; ++i) {
        if (i < NA) __builtin_amdgcn_global_load_lds((const unsigned*)(ap[i] + (kt + 1) * 64), (unsigned*)(ldst + nxt + i * 4096), 16, 0, 0);
        __builtin_amdgcn_global_load_lds((const unsigned*)(bp[i] + (kt + 1) * 64), (unsigned*)(ldst + nxt + OPB + i * 4096), 16, 0, 0);
      }
    }
    const char* As = smem + cur; const char* Bs = smem + cur + OPB;
    bf16x8 a[4][IM], b[4][2];
#pragma unroll
    for (int kk = 0; kk < 4; ++kk)
#pragma unroll
      for (int i = 0; i < 2; ++i) {
        if (i < IM) a[kk][i] = *(const bf16x8*)(As + aoff[i] + (((2 * kk + h) ^ aswz[i]) << 4));
        b[kk][i] = *(const bf16x8*)(Bs + boff[i] + (((2 * kk + h) ^ bswz[i]) << 4));
      }
    __builtin_amdgcn_sched_barrier(0);
    __builtin_amdgcn_s_setprio(1);
#pragma unroll
    for (int kk = 0; kk < 4; ++kk)
#pragma unroll
      for (int i = 0; i < IM; ++i)
#pragma unroll
        for (int j = 0; j < 2; ++j) acc[i][j] = MFMA(a[kk][i], b[kk][j], acc[i][j]);
    __builtin_amdgcn_s_setprio(0);
  }
  __syncthreads();
  float* Cs = (float*)smem;
#pragma unroll
  for (int i = 0; i < IM; ++i)
#pragma unroll
    for (int j = 0; j < 2; ++j)
#pragma unroll
      for (int e = 0; e < 16; ++e) Cs[(wm * (BM / 2) + i * 32 + crow(e, h)) * CS_LD + wn * 64 + j * 32 + r] = acc[i][j][e];
  __syncthreads();
}

template <int K, typename Epi>
DI void gemm_tile_wide(const u16* __restrict__ A, int lda, const u16* __restrict__ Bt, int ldb, int m0, int n0, char* smem, Epi epi) {
  const int tid = otid(), lane = tid & 63, w = tid >> 6, r = lane & 31, h = lane >> 5;
  const int wm = w >> 1, wn = w & 1;
  f32x16 acc[2][4];
#pragma unroll
  for (int i = 0; i < 2; ++i)
#pragma unroll
    for (int j = 0; j < 4; ++j)
#pragma unroll
      for (int e = 0; e < 16; ++e) acc[i][j][e] = 0.f;
  constexpr int NS = K / 32;
  constexpr int AB = 128 * 64;
  constexpr int STB = AB + 256 * 64;
  const int lrow = tid >> 2, cpos = tid & 3;
  const u16* ap[2]; const u16* bp[4];
#pragma unroll
  for (int i = 0; i < 4; ++i) {
    const int row = lrow + 64 * i;
    const int sc = cpos ^ ((row >> 2) & 3);
    if (i < 2) ap[i] = A + (size_t)(m0 + row) * lda + sc * 8;
    bp[i] = Bt + (size_t)(n0 + row) * ldb + sc * 8;
  }
  char* const ldst = smem + tid * 16;
  int aoff[2][2], boff[4][2];
#pragma unroll
  for (int kk = 0; kk < 2; ++kk) {
#pragma unroll
    for (int i = 0; i < 2; ++i) { const int ra_ = wm * 64 + i * 32 + r; aoff[i][kk] = ra_ * 64 + (((2 * kk + h) ^ ((ra_ >> 2) & 3)) << 4); }
#pragma unroll
    for (int j = 0; j < 4; ++j) { const int rb_ = wn * 128 + j * 32 + r; boff[j][kk] = AB + rb_ * 64 + (((2 * kk + h) ^ ((rb_ >> 2) & 3)) << 4); }
  }
  auto issue = [&](int slice, int st) {
#pragma unroll
    for (int i = 0; i < 4; ++i) {
      if (i < 2) __builtin_amdgcn_global_load_lds((const unsigned*)(ap[i] + slice * 32), (unsigned*)(ldst + st + i * 4096), 16, 0, 0);
      __builtin_amdgcn_global_load_lds((const unsigned*)(bp[i] + slice * 32), (unsigned*)(ldst + st + AB + i * 4096), 16, 0, 0);
    }
  };
  __syncthreads();
  issue(0, 0);
  for (int kt = 0; kt < NS; ++kt) {
    asm volatile("s_waitcnt vmcnt(0)" ::: "memory");
    __syncthreads();
    const int cur = (kt & 1) * STB;
    if (kt + 1 < NS) issue(kt + 1, STB - cur);
    const char* Sg = smem + cur;
    bf16x8 a[2][2], b[2][4];
#pragma unroll
    for (int kk = 0; kk < 2; ++kk) {
#pragma unroll
      for (int i = 0; i < 2; ++i) a[kk][i] = *(const bf16x8*)(Sg + aoff[i][kk]);
#pragma unroll
      for (int j = 0; j < 4; ++j) b[kk][j] = *(const bf16x8*)(Sg + boff[j][kk]);
    }
    __builtin_amdgcn_sched_barrier(0);
#pragma unroll
    for (int kk = 0; kk < 2; ++kk)
#pragma unroll
      for (int i = 0; i < 2; ++i)
#pragma unroll
        for (int j = 0; j < 4; ++j) acc[i][j] = MFMA(a[kk][i], b[kk][j], acc[i][j]);
  }
  float* Cs = (float*)smem;
#pragma unroll
  for (int half = 0; half < 2; ++half) {
    __syncthreads();
    if (wn == half) {
#pragma unroll
      for (int i = 0; i < 2; ++i)
#pragma unroll
        for (int j = 0; j < 4; ++j)
#pragma unroll
          for (int e = 0; e < 16; ++e) Cs[(wm * 64 + i * 32 + crow(e, h)) * CS_LD + j * 32 + r] = acc[i][j][e];
    }
    __syncthreads();
    epi(half);
  }
}

DI float half_sum(float v) {
  v += __shfl_xor(v, 16); v += __shfl_xor(v, 8); v += __shfl_xor(v, 4); v += __shfl_xor(v, 2); v += __shfl_xor(v, 1);
  return v;
}
DI float wave_sum(float v) { v = half_sum(v); v += __shfl_xor(v, 32); return v; }

DI void transpose_tile(const float* __restrict__ src, int N, int Kdim, int k0, int n0, u16* __restrict__ dst, int remap, char* smem) {
  float* tl = (float*)smem;
  const int tid = otid();
  __syncthreads();
#pragma unroll
  for (int i = 0; i < 4; ++i) {
    const int kr = i * 16 + (tid >> 4), nc = (tid & 15) * 4;
    f32x4 v = {0.f, 0.f, 0.f, 0.f};
    if (n0 + nc < N) v = __builtin_nontemporal_load((const f32x4*)(src + (size_t)(k0 + kr) * N + n0 + nc));
    tl[(nc + 0) * 65 + kr] = v[0]; tl[(nc + 1) * 65 + kr] = v[1]; tl[(nc + 2) * 65 + kr] = v[2]; tl[(nc + 3) * 65 + kr] = v[3];
  }
  __syncthreads();
  int nr = tid >> 2, kc = (tid & 3) * 16;
  int n = n0 + nr;
  if (n < N) {
    int nrow = remap ? (n < 416 ? n : n + 96) : n;
    float v[16];
#pragma unroll
    for (int e = 0; e < 16; ++e) v[e] = tl[nr * 65 + kc + e];
    uint4 a, b;
    a.x = pk2(v[0], v[1]); a.y = pk2(v[2], v[3]); a.z = pk2(v[4], v[5]); a.w = pk2(v[6], v[7]);
    b.x = pk2(v[8], v[9]); b.y = pk2(v[10], v[11]); b.z = pk2(v[12], v[13]); b.w = pk2(v[14], v[15]);
    u16* d = dst + (size_t)nrow * Kdim + k0 + kc;
    *(uint4*)d = a; *(uint4*)(d + 8) = b;
  }
}

DI void phase_p0(const Params& p, char* smem) {
  const int tid = otid();
  const size_t gtid = (size_t)blockIdx.x * 256 + tid, gsz = (size_t)gridDim.x * 256;
  for (size_t i = gtid; i < (size_t)T * 128; i += gsz) {
    size_t tok = i >> 7; int c = (int)(i & 127) * 8;
    const float* s = tok < TP ? p.x_prompt + tok * 1024 + c : p.x_sample + (tok - TP) * 1024 + c;
    const f32x4 a = __builtin_nontemporal_load((const f32x4*)s), b = __builtin_nontemporal_load((const f32x4*)(s + 4));
    uint4 o; o.x = pk2(a[0], a[1]); o.y = pk2(a[2], a[3]); o.z = pk2(b[0], b[1]); o.w = pk2(b[2], b[3]);
    *(uint4*)(p.xb() + tok * 1024 + c) = o;
  }
  constexpr int NA = 16 * 47, NB = 2 * 8, NC = 256, ND = 1024, NE = 256;
  for (int j = blockIdx.x; j < NA + NB + NC + ND + NE; j += gridDim.x) {
    if (j < NA) transpose_tile(p.w_in_even, 2976, 1024, (j / 47) * 64, (j % 47) * 64, p.Wt_in_e(), 1, smem);
    else if (j < NA + NB) { int q = j - NA; transpose_tile(p.w_uv, 512, 128, (q / 8) * 64, (q % 8) * 64, p.Wt_uv(), 0, smem); }
    else if (j < NA + NB + NC) { int q = j - NA - NB; transpose_tile(p.w_out_even, 1024, 1024, (q / 16) * 64, (q % 16) * 64, p.Wt_out_e(), 0, smem); }
    else if (j < NA + NB + NC + ND) { int q = j - NA - NB - NC; transpose_tile(p.w_in_odd, 4096, 1024, (q / 64) * 64, (q % 64) * 64, p.Wt_in_o(), 0, smem); }
    else { int q = j - NA - NB - NC - ND; transpose_tile(p.w_out_odd, 1024, 1024, (q / 16) * 64, (q % 16) * 64, p.Wt_out_o(), 0, smem); }
  }
  for (size_t i = gtid; i < (size_t)96 * 128; i += gsz) *(uint4*)(p.Wt_in_e() + (size_t)416 * 1024 + i * 8) = make_uint4(0, 0, 0, 0);
  for (size_t i = gtid; i < (size_t)1280 * 256; i += gsz) {
    int o = (int)(i >> 8), l = (int)(i & 255);
    int hh = o / 160, c = o % 160;
    float g = p.q_g[l];
    float acc;
    if (c < 128) {
      const float* a = p.w_uq + (size_t)l * 768 + hh * 96;
      const float* b = p.w_uk + (size_t)c * 512 + hh * 64;
      acc = 0.f;
#pragma unroll
      for (int n = 0; n < 64; n += 4) {
        const float4 av = *(const float4*)(a + n), bv = *(const float4*)(b + n);
        acc += av.x * bv.x; acc += av.y * bv.y; acc += av.z * bv.z; acc += av.w * bv.w;
      }
    } else {
      acc = p.w_uq[(size_t)l * 768 + hh * 96 + 64 + (c - 128)];
    }
    bf2_t v; v[0] = (__bf16)(acc * g * QS_MLA); v[1] = v[0];
    p.Wc()[i] = (u16)(__builtin_bit_cast(unsigned, v) & 0xffffu);
  }
  for (size_t i = gtid; i < (size_t)4096 * 24; i += gsz) {
    int pos = (int)(i / 24), j = (int)(i % 24);
    float t;
    if (j < 16) { t = (-9.210340371976184f) * (float)j; t = t * 0.0625f; }
    else { t = (-13.122363377404328f) * (float)(j - 16); t = t * 0.125f; }
    float inv = expf(t);
    float ang = (float)pos * inv;
    p.ropeC()[i] = cosf(ang); p.ropeS()[i] = sinf(ang);
  }
  if (gtid == 0) {
    float s0 = 0.f, s1 = 0.f;
    for (int d = 0; d < 64; ++d) { s0 += p.lam_q[d] * p.lam_k[d]; s1 += p.lam_q[64 + d] * p.lam_k[64 + d]; }
    p.lam()[0] = expf(s0) - expf(s1) + LAM_INIT;
  }
}

DI void st_nt4(float* d, float4 v) {
  f32x4 t = {v.x, v.y, v.z, v.w};
  __builtin_nontemporal_store(t, (f32x4*)d);
}
DI void st_bf4(u16* d, float a, float b, float c, float e) { *(uint2*)d = pack4(a, b, c, e); }

DI void epi_e1a(const Params& p, int mt, int nt, const float* Cs, int row0 = 0, int npass = 16) {
  const int tid = otid(), c4 = (tid & 31) * 4;
  for (int pp = 0; pp < npass; ++pp) {
    const int row = pp * 8 + (tid >> 5);
    const int tok = mt * 128 + row0 + row;
    const bool smp = tok >= TP;
    const int pos = smp ? 2048 + ((tok - TP) & 15) : (tok & 4095);
    const float* cr = Cs + row * CS_LD;
    float4 v = *(const float4*)(cr + c4);
    if (nt < 2) {
      st_bf4(p.qlat() + (size_t)tok * 256 + nt * 128 + c4, v.x, v.y, v.z, v.w);
      float ss = half_sum(v.x * v.x + v.y * v.y + v.z * v.z + v.w * v.w);
      if ((tid & 31) == 0) p.ssq()[tok * 2 + nt] = ss;
    } else if (nt == 2) {
      float ss = half_sum(v.x * v.x + v.y * v.y + v.z * v.z + v.w * v.w);
      float rstd = rsqrtf(ss * (1.f / 128.f) + EPS);
      float4 g = *(const float4*)(p.kv_g + c4);
      float4 o = make_float4(v.x * rstd * g.x, v.y * rstd * g.y, v.z * rstd * g.z, v.w * rstd * g.w);
      float* d = smp ? p.out + OFF_CKV_S + (size_t)(tok - TP) * 128 + c4 : p.out + OFF_CKV_P + (size_t)tok * 128 + c4;
      st_nt4(d, o);
      st_bf4(p.Kmla() + (size_t)tok * 160 + c4, o.x, o.y, o.z, o.w);
    } else if (nt == 3) {
      if (c4 < 32) {
        const bool second = c4 >= 16; const int i0 = c4 & 15;
        float o[4];
#pragma unroll
        for (int e = 0; e < 4; ++e) {
          int i = i0 + e;
          float x1 = cr[i], x2 = cr[i + 16];
          float cs = p.ropeC()[pos * 24 + i], sn = p.ropeS()[pos * 24 + i];
          o[e] = second ? (x1 * sn + x2 * cs) : (x1 * cs - x2 * sn);
        }
        float* d = smp ? p.out + OFF_KR_S + (size_t)(tok - TP) * 32 + c4 : p.out + OFF_KR_P + (size_t)tok * 32 + c4;
        st_nt4(d, make_float4(o[0], o[1], o[2], o[3]));
        st_bf4(p.Kmla() + (size_t)tok * 160 + 128 + c4, o[0], o[1], o[2], o[3]);
      }
    } else if (nt < 8) {
      st_bf4(p.gm() + (size_t)tok * 512 + (nt - 4) * 128 + c4, silu(v.x), silu(v.y), silu(v.z), silu(v.w));
    } else if (nt < 16) {
      const bool isq = nt < 12;
      const int c512 = (nt - (isq ? 8 : 12)) * 128 + c4;
      const int d = c512 & 63;
      float o[4] = {v.x, v.y, v.z, v.w};
      if (d < 16) {
        const bool second = d >= 8; const int i0 = d & 7; const int gb = c4 - d;
#pragma unroll
        for (int e = 0; e < 4; ++e) {
          int i = i0 + e;
          float x1 = cr[gb + i], x2 = cr[gb + 8 + i];
          float cs = p.ropeC()[pos * 24 + 16 + i], sn = p.ropeS()[pos * 24 + 16 + i];
          o[e] = second ? (x1 * sn + x2 * cs) : (x1 * cs - x2 * sn);
        }
      }
      if (isq) {
        st_bf4(p.dqb() + (size_t)tok * 512 + c512, o[0] * QS_64, o[1] * QS_64, o[2] * QS_64, o[3] * QS_64);
      } else {
        float* dd = smp ? p.out + OFF_DK_S + (size_t)(tok - TP) * 512 + c512 : p.out + OFF_DK_P + (size_t)tok * 512 + c512;
        st_nt4(dd, make_float4(o[0], o[1], o[2], o[3]));
        st_bf4(p.dkb() + (size_t)tok * 512 + c512, o[0], o[1], o[2], o[3]);
      }
    } else if (nt < 20) {
      const int c512 = (nt - 16) * 128 + c4;
      float* dd = smp ? p.out + OFF_DV_S + (size_t)(tok - TP) * 512 + c512 : p.out + OFF_DV_P + (size_t)tok * 512 + c512;
      st_nt4(dd, v);
      st_bf4(p.dvb() + (size_t)tok * 512 + c512, v.x, v.y, v.z, v.w);
    } else {
      st_bf4(p.gd() + (size_t)tok * 512 + (nt - 20) * 128 + c4, silu(v.x), silu(v.y), silu(v.z), silu(v.w));
    }
  }
}

DI void epi_e1b(const Params& p, int mt, int nt, const float* Cs) {
  const int tid = otid(), c4 = (tid & 31) * 4;
  for (int pp = 0; pp < 16; ++pp) {
    const int row = pp * 8 + (tid >> 5);
    const int tok = mt * 128 + row;
    const bool smp = tok >= TP;
    const int pos = smp ? 2048 + ((tok - TP) & 15) : (tok & 4095);
    const float* cr = Cs + row * CS_LD;
    const float rstd = rsqrtf((p.ssq()[tok * 2] + p.ssq()[tok * 2 + 1]) * (1.f / 256.f) + EPS);
    float4 v = *(const float4*)(cr + c4);
    const int oc = nt * 128 + c4;
    const int c = oc % 160;
    float o[4] = {v.x * rstd, v.y * rstd, v.z * rstd, v.w * rstd};
    if (c >= 128) {
      const int cc = c - 128; const bool second = cc >= 16; const int i0 = cc & 15; const int gb = c4 - cc;
#pragma unroll
      for (int e = 0; e < 4; ++e) {
        int i = i0 + e;
        float x1 = cr[gb + i] * rstd, x2 = cr[gb + 16 + i] * rstd;
        float cs = p.ropeC()[pos * 24 + i], sn = p.ropeS()[pos * 24 + i];
        o[e] = second ? (x1 * sn + x2 * cs) : (x1 * cs - x2 * sn);
      }
    }
    st_bf4(p.Qmla() + (size_t)tok * 1280 + oc, o[0], o[1], o[2], o[3]);
  }
}

DI void epi_out(const Params& p, int mt, int nt, const float* Cs, int layer, int row0 = 0, int npass = 16) {
  const int tid = otid(), c4 = (tid & 31) * 4;
  for (int pp = 0; pp < npass; ++pp) {
    const int row = pp * 8 + (tid >> 5);
    const int tok = mt * 128 + row0 + row;
    const int col = nt * 128 + c4;
    float4 v = *(const float4*)(Cs + row * CS_LD + c4);
    float4 x;
    if (layer == 0) { const f32x4 t = __builtin_nontemporal_load((const f32x4*)(tok < TP ? p.x_prompt + (size_t)tok * 1024 + col : p.x_sample + (size_t)(tok - TP) * 1024 + col)); x = make_float4(t[0], t[1], t[2], t[3]); }
    else { const uint2 yb = *(const uint2*)(p.y0b() + (size_t)tok * 1024 + col); x = make_float4(bflo(yb.x), bfhi(yb.x), bflo(yb.y), bfhi(yb.y)); }
    st_bf4((u16*)p.pre() + (size_t)tok * 1024 + col, ALPHA * x.x + v.x, ALPHA * x.y + v.y, ALPHA * x.z + v.z, ALPHA * x.w + v.w);
  }
}

DI void epi_o1(const Params& p, int mt, int nt, const float* Cs, int row0 = 0, int npass = 16) {
  const int tid = otid(), c4 = (tid & 31) * 4;
  for (int pp = 0; pp < npass; ++pp) {
    const int row = pp * 8 + (tid >> 5);
    const int tok = mt * 128 + row0 + row;
    const bool smp = tok >= TP;
    float4 v = *(const float4*)(Cs + row * CS_LD + c4);
    const int sec = nt >> 3; const int col = (nt & 7) * 128 + c4;
    if (sec == 0) st_bf4(p.sqb() + (size_t)tok * 1024 + col, v.x * QS_64, v.y * QS_64, v.z * QS_64, v.w * QS_64);
    else if (sec == 1) {
      float* d = smp ? p.out + OFF_SK_S + (size_t)(tok - TP) * 1024 + col : p.out + OFF_SK_P + (size_t)tok * 1024 + col;
      st_nt4(d, v); st_bf4(p.skb() + (size_t)tok * 1024 + col, v.x, v.y, v.z, v.w);
    } else if (sec == 2) {
      float* d = smp ? p.out + OFF_SV_S + (size_t)(tok - TP) * 1024 + col : p.out + OFF_SV_P + (size_t)tok * 1024 + col;
      st_nt4(d, v); st_bf4(p.svb() + (size_t)tok * 1024 + col, v.x, v.y, v.z, v.w);
    } else st_bf4(p.sgb() + (size_t)tok * 1024 + col, silu(v.x), silu(v.y), silu(v.z), silu(v.w));
  }
}

DI void phase_ln(const Params& p, int layer) {
  const int tid = otid(); const int lane = tid & 63, w = tid >> 6;
  const float* g = layer == 0 ? p.ln_e_g : p.ln_o_g;
  const float* bb = layer == 0 ? p.ln_e_b : p.ln_o_b;
  for (int row = blockIdx.x * 4 + w; row < T; row += gridDim.x * 4) {
    const u16* s = (const u16*)p.pre() + (size_t)row * 1024;
    float4 v[4];
    float sum = 0.f;
#pragma unroll
    for (int i = 0; i < 4; ++i) {
      typedef __attribute__((ext_vector_type(2))) unsigned u32x2_t;
      const u32x2_t qq = __builtin_nontemporal_load((const u32x2_t*)(s + lane * 4 + 256 * i));
      const uint2 q = make_uint2(qq[0], qq[1]);
      v[i] = make_float4(bflo(q.x), bfhi(q.x), bflo(q.y), bfhi(q.y));
      sum += v[i].x + v[i].y + v[i].z + v[i].w;
    }
    const float mu = wave_sum(sum) * (1.f / 1024.f);
    float sq = 0.f;
#pragma unroll
    for (int i = 0; i < 4; ++i) { v[i].x -= mu; v[i].y -= mu; v[i].z -= mu; v[i].w -= mu; sq += v[i].x * v[i].x + v[i].y * v[i].y + v[i].z * v[i].z + v[i].w * v[i].w; }
    const float rstd = rsqrtf(wave_sum(sq) * (1.f / 1024.f) + EPS);
#pragma unroll
    for (int i = 0; i < 4; ++i) {
      const int c = lane * 4 + 256 * i;
      float4 gg = *(const float4*)(g + c), b4 = *(const float4*)(bb + c);
      float4 y = make_float4(v[i].x * rstd * gg.x + b4.x, v[i].y * rstd * gg.y + b4.y, v[i].z * rstd * gg.z + b4.z, v[i].w * rstd * gg.w + b4.w);
      if (layer == 0) {
        st_bf4(p.y0b() + (size_t)row * 1024 + c, y.x, y.y, y.z, y.w);
      } else {
        float* d = row < TP ? p.out + OFF_YP + (size_t)row * 1024 + c : p.out + OFF_YS + (size_t)(row - TP) * 1024 + c;
        st_nt4(d, y);
      }
    }
  }
}

template <int W>
DI void load_bf16(int tid, char* dst, int rs, int coff, const u16* __restrict__ src, size_t ld, int nvalid) {
  constexpr int CPR = W / 8; constexpr int TOT = 64 * CPR;
#pragma unroll
  for (int c0 = 0; c0 < TOT; c0 += 256) {
    int c = c0 + tid;
    if (c < TOT) {
      int row = c / CPR, cc = c % CPR;
      uint4 v = make_uint4(0, 0, 0, 0);
      if (row < nvalid) v = *(const uint4*)(src + (size_t)row * ld + cc * 8);
      *(uint4*)(dst + row * rs + coff + cc * 16) = v;
    }
  }
}
template <int W>
DI void load_f32(int tid, char* dst, int rs, int coff, const float* __restrict__ src, size_t ld, int nvalid) {
  constexpr int CPR = W / 8; constexpr int TOT = 64 * CPR;
#pragma unroll
  for (int c0 = 0; c0 < TOT; c0 += 256) {
    int c = c0 + tid;
    if (c < TOT) {
      int row = c / CPR, cc = c % CPR;
      uint4 v = make_uint4(0, 0, 0, 0);
      if (row < nvalid) {
        const float* s = src + (size_t)row * ld + cc * 8;
        float4 a = *(const float4*)s, b = *(const float4*)(s + 4);
        v.x = pk2(a.x, a.y); v.y = pk2(a.z, a.w); v.z = pk2(b.x, b.y); v.w = pk2(b.z, b.w);
      }
      *(uint4*)(dst + row * rs + coff + cc * 16) = v;
    }
  }
}

template <int NK>
DI void qk_half(const char* kb, int rs, const bf16x8 (&qf)[NK], f32x16& s, int r, int h) {
  const int pr = (r & 19) | ((r & 4) << 1) | ((r & 8) >> 1);
#pragma unroll
  for (int e = 0; e < 16; ++e) s[e] = 0.f;
  bf16x8 kf[NK];
#pragma unroll
  for (int kk = 0; kk < NK; ++kk) kf[kk] = *(const bf16x8*)(kb + pr * rs + kk * 32 + h * 16);
  __builtin_amdgcn_sched_barrier(0);
  __builtin_amdgcn_s_setprio(1);
#pragma unroll
  for (int kk = 0; kk < NK; ++kk) s = MFMA(kf[kk], qf[kk], s);
  __builtin_amdgcn_s_setprio(0);
}
template <int NDT>
DI void pv_half(const char* vb, int rs, const bf16x8 (&pf)[2], f32x16 (&o)[NDT], int lane) {
  const int i16 = lane & 15, q4 = i16 >> 2, p4 = i16 & 3, blk = (lane >> 4) & 1, h = lane >> 5;
  const char* base = vb + (8 * h + q4) * rs + (16 * blk + 4 * p4) * 2;
  s16x4 lo[NDT][2], hi[NDT][2];
#pragma unroll
  for (int dt = 0; dt < NDT; ++dt)
#pragma unroll
    for (int s2 = 0; s2 < 2; ++s2) {
      const char* ad = base + (16 * s2) * rs + dt * 64;
      lo[dt][s2] = __builtin_amdgcn_ds_read_tr16_b64_v4i16((LAS s16x4*)(ad));
      hi[dt][s2] = __builtin_amdgcn_ds_read_tr16_b64_v4i16((LAS s16x4*)(ad + 4 * rs));
    }
  __builtin_amdgcn_sched_barrier(0);
  __builtin_amdgcn_s_setprio(1);
#pragma unroll
  for (int s2 = 0; s2 < 2; ++s2)
#pragma unroll
    for (int dt = 0; dt < NDT; ++dt) {
      bf16x8 a = __builtin_shufflevector(lo[dt][s2], hi[dt][s2], 0, 1, 2, 3, 4, 5, 6, 7);
      o[dt] = MFMA(a, pf[s2], o[dt]);
    }
  __builtin_amdgcn_s_setprio(0);
}
template <int NDT>
DI void softmax_half(f32x16& s, float& m, float& l, f32x16 (&o)[NDT], bf16x8 (&pf)[2], int nvalid, int h) {
  if (nvalid < 32) {
#pragma unroll
    for (int i = 0; i < 16; ++i) {
      int key = (i & 7) + 8 * h + 16 * (i >> 3);
      if (key >= nvalid) s[i] = -1e30f;
    }
  }
  float mx = -1e30f;
#pragma unroll
  for (int i = 0; i < 16; ++i) mx = fmaxf(mx, s[i]);
  mx = x32_max(mx);
  if (!__all(mx - m <= 6.f)) {
    const float mnew = fmaxf(m, mx);
    const float alpha = ex2(m - mnew);
    m = mnew;
    l *= alpha;
#pragma unroll
    for (int dt = 0; dt < NDT; ++dt)
#pragma unroll
      for (int i = 0; i < 16; ++i) o[dt][i] *= alpha;
  }
  const float mn = m;
  float ls = 0.f;
#pragma unroll
  for (int i = 0; i < 16; ++i) { float pv = ex2(s[i] - mn); s[i] = pv; ls += pv; }
#pragma unroll
  for (int s2 = 0; s2 < 2; ++s2)
    pf[s2] = pack8(s[8 * s2], s[8 * s2 + 1], s[8 * s2 + 2], s[8 * s2 + 3], s[8 * s2 + 4], s[8 * s2 + 5], s[8 * s2 + 6], s[8 * s2 + 7]);
  l += ls;
}
#define SGB_MFMA_VALU(nv) do { __builtin_amdgcn_sched_group_barrier(0x008, 1, 0); __builtin_amdgcn_sched_group_barrier(0x002, (nv), 0); } while (0)
template <int NDT>
DI void sm_finish(f32x16& s, f32x16& pe, float mx, float& m, float& l, f32x16 (&o)[NDT], bf16x8 (&pf)[2]) {
  if (!__all(mx - m <= 6.f)) {
    const float mnew = fmaxf(m, mx);
    const float alpha = ex2(m - mnew);
    m = mnew;
    l *= alpha;
#pragma unroll
    for (int dt = 0; dt < NDT; ++dt)
#pragma unroll
      for (int i = 0; i < 16; ++i) o[dt][i] *= alpha;
#pragma unroll
    for (int i = 0; i < 16; ++i) pe[i] = ex2(s[i] - mnew);
  }
  float ls = 0.f;
#pragma unroll
  for (int i = 0; i < 16; ++i) ls += pe[i];
  l += ls;
#pragma unroll
  for (int s2 = 0; s2 < 2; ++s2)
    pf[s2] = pack8(pe[8 * s2], pe[8 * s2 + 1], pe[8 * s2 + 2], pe[8 * s2 + 3], pe[8 * s2 + 4], pe[8 * s2 + 5], pe[8 * s2 + 6], pe[8 * s2 + 7]);
}
template <int NK, int NDT>
DI void attn_tile64(const char* kb, int rsk, const char* vb, int rsv, const bf16x8 (&qf)[NK], float& m, float& l, f32x16 (&o)[NDT], int lane) {
  const int r = lane & 31, h = lane >> 5;
  const int pr = (r & 19) | ((r & 4) << 1) | ((r & 8) >> 1);
  const int i16 = lane & 15, q4 = i16 >> 2, p4 = i16 & 3, blk = (lane >> 4) & 1;
  const char* krow = kb + pr * rsk + h * 16;
  const char* vbase = vb + (8 * h + q4) * rsv + (16 * blk + 4 * p4) * 2;
  f32x16 s0, s1;
#pragma unroll
  for (int e = 0; e < 16; ++e) { s0[e] = 0.f; s1[e] = 0.f; }
  {
    bf16x8 kf[NK];
#pragma unroll
    for (int kk = 0; kk < NK; ++kk) kf[kk] = *(const bf16x8*)(krow + kk * 32);
    __builtin_amdgcn_sched_barrier(0);
#pragma unroll
    for (int kk = 0; kk < NK; ++kk) s0 = MFMA(kf[kk], qf[kk], s0);
  }
  bf16x8 kf1[NK];
#pragma unroll
  for (int kk = 0; kk < NK; ++kk) kf1[kk] = *(const bf16x8*)(krow + 32 * rsk + kk * 32);
  __builtin_amdgcn_sched_barrier(0);
#pragma unroll
  for (int kk = 0; kk < NK; ++kk) s1 = MFMA(kf1[kk], qf[kk], s1);
  float mx0 = -1e30f;
#pragma unroll
  for (int i = 0; i < 16; ++i) mx0 = fmaxf(mx0, s0[i]);
  mx0 = x32_max(mx0);
  f32x16 pe0;
#pragma unroll
  for (int i = 0; i < 16; ++i) { pe0[i] = ex2(s0[i] - m); asm volatile("" : "+v"(pe0[i])); }
#pragma unroll
  for (int kk = 0; kk < NK; ++kk) SGB_MFMA_VALU((48 + NK - 1) / NK);
  __builtin_amdgcn_sched_barrier(0);
  bf16x8 pf0[2];
  sm_finish<NDT>(s0, pe0, mx0, m, l, o, pf0);
  s16x4 lo[NDT][2], hi[NDT][2];
#pragma unroll
  for (int dt = 0; dt < NDT; ++dt)
#pragma unroll
    for (int s2 = 0; s2 < 2; ++s2) {
      const char* ad = vbase + (16 * s2) * rsv + dt * 64;
      lo[dt][s2] = __builtin_amdgcn_ds_read_tr16_b64_v4i16((LAS s16x4*)(ad));
      hi[dt][s2] = __builtin_amdgcn_ds_read_tr16_b64_v4i16((LAS s16x4*)(ad + 4 * rsv));
    }
  __builtin_amdgcn_sched_barrier(0);
#pragma unroll
  for (int s2 = 0; s2 < 2; ++s2)
#pragma unroll
    for (int dt = 0; dt < NDT; ++dt) {
      bf16x8 a = __builtin_shufflevector(lo[dt][s2], hi[dt][s2], 0, 1, 2, 3, 4, 5, 6, 7);
      o[dt] = MFMA(a, pf0[s2], o[dt]);
    }
  float mx1 = -1e30f;
#pragma unroll
  for (int i = 0; i < 16; ++i) mx1 = fmaxf(mx1, s1[i]);
  mx1 = x32_max(mx1);
  f32x16 pe1;
#pragma unroll
  for (int i = 0; i < 16; ++i) { pe1[i] = ex2(s1[i] - m); asm volatile("" : "+v"(pe1[i])); }
#pragma unroll
  for (int k = 0; k < 2 * NDT; ++k) SGB_MFMA_VALU((48 + 2 * NDT - 1) / (2 * NDT));
  __builtin_amdgcn_sched_barrier(0);
  bf16x8 pf1[2];
  sm_finish<NDT>(s1, pe1, mx1, m, l, o, pf1);
  pv_half<NDT>(vb + 32 * rsv, rsv, pf1, o, lane);
}

template <bool MASKED>
DI void sb_half(f32x16& s, float& carry, bf16x8 (&pf)[2], int limit, int h) {
  f32x16 rem;
#pragma unroll
  for (int i = 0; i < 16; ++i) {
    const float z = fmaxf(s[i], -100.f);
    const float t = ex2(-z);
    const float beta = __builtin_amdgcn_rcpf(1.f + t);
    const float omb = t * beta;
    if (MASKED) {
      const int key = (i & 7) + 8 * h + 16 * (i >> 3);
      const bool valid = key < limit;
      s[i] = valid ? beta : 0.f;
      rem[i] = valid ? omb : 1.f;
    } else { s[i] = beta; rem[i] = omb; }
  }
  float Tt[2], To[2];
#pragma unroll
  for (int u = 0; u < 2; ++u) {
    float run = 1.f;
#pragma unroll
    for (int j = 7; j >= 0; --j) { float tmp = rem[8 * u + j]; rem[8 * u + j] = run; run *= tmp; }
    Tt[u] = run;
  }
#pragma unroll
  for (int u = 0; u < 2; ++u) To[u] = x32_other(Tt[u], h);
  float acc = carry;
#pragma unroll
  for (int u = 1; u >= 0; --u) {
    const float off = acc * (h == 0 ? To[u] : 1.f);
#pragma unroll
    for (int j = 0; j < 8; ++j) s[8 * u + j] = s[8 * u + j] * rem[8 * u + j] * off;
    acc *= Tt[u] * To[u];
  }
  carry = acc;
#pragma unroll
  for (int s2 = 0; s2 < 2; ++s2)
    pf[s2] = pack8(s[8 * s2], s[8 * s2 + 1], s[8 * s2 + 2], s[8 * s2 + 3], s[8 * s2 + 4], s[8 * s2 + 5], s[8 * s2 + 6], s[8 * s2 + 7]);
}

DI u32x4 ldg16(const void* p) { return *(const u32x4*)p; }
DI u32x4 ldg16_nt(const void* p) { return __builtin_nontemporal_load((const u32x4*)p); }
DI u32x4 cvt8(u32x4 a, u32x4 b) {
  u32x4 o;
  o[0] = pk2(__uint_as_float(a[0]), __uint_as_float(a[1])); o[1] = pk2(__uint_as_float(a[2]), __uint_as_float(a[3]));
  o[2] = pk2(__uint_as_float(b[0]), __uint_as_float(b[1])); o[3] = pk2(__uint_as_float(b[2]), __uint_as_float(b[3]));
  return o;
}
struct Stage128 { u32x4 v[8]; };
DI void issue128_full(Stage128& st, int tid, const u16* ksrc, const u16* vsrc, size_t ld) {
#pragma unroll
  for (int i = 0; i < 4; ++i) {
    const int c = tid + 256 * i, row = c >> 4, cc = c & 15;
    st.v[i] = ldg16(ksrc + (size_t)row * ld + cc * 8);
    st.v[4 + i] = ldg16(vsrc + (size_t)row * ld + cc * 8);
  }
}
DI void commit128_full(const Stage128& st, int tid, char* Kt, int rsk, char* Vt, int rsv) {
#pragma unroll
  for (int i = 0; i < 4; ++i) {
    const int c = tid + 256 * i, row = c >> 4, cc = c & 15;
    *(u32x4*)(Kt + row * rsk + cc * 16) = st.v[i];
    *(u32x4*)(Vt + row * rsv + cc * 16) = st.v[4 + i];
  }
}
DI void issue128_bf16(Stage128& st, int tid, const u16* ksrc, const u16* vsrc, size_t ld, int nrows, int nvalid) {
#pragma unroll
  for (int i = 0; i < 4; ++i) {
    const int c = tid + 256 * i, row = c >> 4, cc = c & 15;
    u32x4 z = {0u, 0u, 0u, 0u};
    const bool ok = (row < nvalid) && (row < nrows);
    st.v[i] = ok ? ldg16(ksrc + (size_t)row * ld + cc * 8) : z;
    st.v[4 + i] = ok ? ldg16(vsrc + (size_t)row * ld + cc * 8) : z;
  }
}
DI void commit128_bf16(const Stage128& st, int tid, char* Kt, int rsk, char* Vt, int rsv, int nrows) {
#pragma unroll
  for (int i = 0; i < 4; ++i) {
    const int c = tid + 256 * i, row = c >> 4, cc = c & 15;
    if (row < nrows) {
      *(u32x4*)(Kt + row * rsk + cc * 16) = st.v[i];
      *(u32x4*)(Vt + row * rsv + cc * 16) = st.v[4 + i];
    }
  }
}
DI void issue128_f32(Stage128& st, int tid, const float* ksrc, const float* vsrc, size_t ld) {
#pragma unroll
  for (int i = 0; i < 2; ++i) {
    const int c = tid + 256 * i, row = c >> 4, cc = c & 15;
    const float* kp = ksrc + (size_t)row * ld + cc * 8;
    const float* vp = vsrc + (size_t)row * ld + cc * 8;
    st.v[2 * i] = ldg16_nt(kp); st.v[2 * i + 1] = ldg16_nt(kp + 4);
    st.v[4 + 2 * i] = ldg16_nt(vp); st.v[4 + 2 * i + 1] = ldg16_nt(vp + 4);
  }
}
DI void commit128_f32(const Stage128& st, int tid, char* Kt, int rsk, char* Vt, int rsv) {
#pragma unroll
  for (int i = 0; i < 2; ++i) {
    const int c = tid + 256 * i, row = c >> 4, cc = c & 15;
    *(u32x4*)(Kt + row * rsk + cc * 16) = cvt8(st.v[2 * i], st.v[2 * i + 1]);
    *(u32x4*)(Vt + row * rsv + cc * 16) = cvt8(st.v[4 + 2 * i], st.v[4 + 2 * i + 1]);
  }
}
struct Stage160 { u32x4 v[6]; };
DI void issue160_full(Stage160& st, int tid, const u16* src) {
#pragma unroll
  for (int i = 0; i < 5; ++i) {
    const int c = tid + 256 * i, row = c / 20, cc = c % 20;
    st.v[i] = ldg16(src + (size_t)row * 160 + cc * 8);
  }
}
DI void commit160_full(const Stage160& st, int tid, char* Kt, int rs) {
#pragma unroll
  for (int i = 0; i < 5; ++i) {
    const int c = tid + 256 * i, row = c / 20, cc = c % 20;
    *(u32x4*)(Kt + row * rs + cc * 16) = st.v[i];
  }
}
DI void issue160_bf16(Stage160& st, int tid, const u16* src, int nrows, int nvalid) {
#pragma unroll
  for (int i = 0; i < 5; ++i) {
    const int c = tid + 256 * i, row = c / 20, cc = c % 20;
    u32x4 z = {0u, 0u, 0u, 0u};
    st.v[i] = (row < nvalid && row < nrows) ? ldg16(src + (size_t)row * 160 + cc * 8) : z;
  }
}
DI void commit160_bf16(const Stage160& st, int tid, char* Kt, int rs, int nrows) {
#pragma unroll
  for (int i = 0; i < 5; ++i) {
    const int c = tid + 256 * i, row = c / 20, cc = c % 20;
    if (row < nrows) *(u32x4*)(Kt + row * rs + cc * 16) = st.v[i];
  }
}
DI void issue160_f32(Stage160& st, int tid, const float* ckv, const float* kr) {
#pragma unroll
  for (int i = 0; i < 2; ++i) {
    const int c = tid + 256 * i, row = c >> 4, cc = c & 15;
    const float* kp = ckv + (size_t)row * 128 + cc * 8;
    st.v[2 * i] = ldg16_nt(kp); st.v[2 * i + 1] = ldg16_nt(kp + 4);
  }
  {
    const int c = tid & 127, row = c >> 2, cc = c & 3;
    const float* kp = kr + (size_t)row * 32 + cc * 8;
    st.v[4] = ldg16_nt(kp); st.v[5] = ldg16_nt(kp + 4);
  }
}
DI void commit160_f32(const Stage160& st, int tid, char* Kt, int rs) {
#pragma unroll
  for (int i = 0; i < 2; ++i) {
    const int c = tid + 256 * i, row = c >> 4, cc = c & 15;
    *(u32x4*)(Kt + row * rs + cc * 16) = cvt8(st.v[2 * i], st.v[2 * i + 1]);
  }
  {
    const int c = tid & 127, row = c >> 2, cc = c & 3;
    *(u32x4*)(Kt + row * rs + 256 + cc * 16) = cvt8(st.v[4], st.v[5]);
  }
}

template <bool SMP>
DI void run_mla(const Params& p, int b, int qb, int hp, char* smem) {
  const int tid = otid(), lane = tid & 63, w = tid >> 6, r = lane & 31, h = lane >> 5;
  int head, tok;
  if (!SMP) { head = 2 * hp + (w >> 1); tok = b * 4096 + qb * 64 + (w & 1) * 32 + r; }
  else { head = 2 * w + (r >> 4); tok = TP + b * 16 + (r & 15); }
  const u16* qptr = p.Qmla() + (size_t)tok * 1280 + head * 160;
  f32x16 o[4];
#pragma unroll
  for (int dt = 0; dt < 4; ++dt)
#pragma unroll
    for (int i = 0; i < 16; ++i) o[dt][i] = 0.f;
  float m = -1e30f, l = 0.f;
  constexpr int RS = 336;
  const int niter = SMP ? 65 : qb + 1;
  Stage160 st;
  constexpr int TILEB = 64 * RS;
  auto issue = [&](int t) {
    if (!SMP) issue160_full(st, tid, p.Kmla() + (size_t)(b * 4096 + t * 64) * 160);
    else if (t < 64) issue160_f32(st, tid, p.c_ckv + (size_t)(b * 2048 + t * 32) * 128, p.c_krope + (size_t)(b * 2048 + t * 32) * 32);
    else issue160_bf16(st, tid, p.Kmla() + (size_t)(TP + b * 16) * 160, 32, 16);
  };
  auto commit = [&](int t, char* dst) {
    if (!SMP) commit160_full(st, tid, dst, RS);
    else if (t < 64) commit160_f32(st, tid, dst, RS);
    else commit160_bf16(st, tid, dst, RS, 32);
  };
  issue(0);
  bf16x8 qf[10];
#pragma unroll
  for (int kk = 0; kk < 10; ++kk) qf[kk] = *(const bf16x8*)(qptr + kk * 16 + h * 8);
  commit(0, smem);
#pragma unroll
  for (int kk = 0; kk < 10; ++kk) asm volatile("" : "+v"(qf[kk]));
  if (niter > 1) issue(1);
  __syncthreads();
  for (int it = 0; it < niter; ++it) {
    const char* cur = smem + (it & 1) * TILEB;
    const int nhalf = SMP ? 1 : 2;
    const int nvalid = (SMP && it == 64) ? 16 : 32;
    if (nhalf == 2) {
      attn_tile64<10, 4>(cur, RS, cur, RS, qf, m, l, o, lane);
    } else {
      f32x16 s;
      qk_half<10>(cur, RS, qf, s, r, h);
      bf16x8 pf[2];
      softmax_half<4>(s, m, l, o, pf, nvalid, h);
      pv_half<4>(cur, RS, pf, o, lane);
    }
    if (it + 1 < niter) {
      commit(it + 1, smem + ((it + 1) & 1) * TILEB);
      if (it + 2 < niter) issue(it + 2);
    }
    __syncthreads();
  }
  const float inv = 1.f / x32_sum(l);
  const int npass = SMP ? 2 : 1;
  for (int pass = 0; pass < npass; ++pass) {
    const int hd = SMP ? 2 * w + pass : head;
    f32x16 res[2];
#pragma unroll
    for (int vt = 0; vt < 2; ++vt)
#pragma unroll
      for (int i = 0; i < 16; ++i) res[vt][i] = 0.f;
#pragma unroll
    for (int ct = 0; ct < 4; ++ct)
#pragma unroll
      for (int s2 = 0; s2 < 2; ++s2) {
        bf16x8 bfr = pack8(o[ct][8 * s2] * inv, o[ct][8 * s2 + 1] * inv, o[ct][8 * s2 + 2] * inv, o[ct][8 * s2 + 3] * inv,
                           o[ct][8 * s2 + 4] * inv, o[ct][8 * s2 + 5] * inv, o[ct][8 * s2 + 6] * inv, o[ct][8 * s2 + 7] * inv);
#pragma unroll
        for (int vt = 0; vt < 2; ++vt) {
          const u16* wp = p.Wt_uv() + (size_t)(hd * 64 + vt * 32 + r) * 128 + ct * 32 + 16 * s2 + 4 * h;
          s16x4 lo = *(const s16x4*)wp, hi = *(const s16x4*)(wp + 8);
          bf16x8 a = __builtin_shufflevector(lo, hi, 0, 1, 2, 3, 4, 5, 6, 7);
          res[vt] = MFMA(a, bfr, res[vt]);
        }
      }
    if (!SMP || (r >> 4) == pass) {
#pragma unroll
      for (int vt = 0; vt < 2; ++vt)
#pragma unroll
        for (int i4 = 0; i4 < 4; ++i4) {
          const int v0 = vt * 32 + 8 * i4 + 4 * h;
          uint2 g = *(const uint2*)(p.gm() + (size_t)tok * 512 + hd * 64 + v0);
          st_bf4(p.A2() + (size_t)tok * 1024 + hd * 64 + v0, res[vt][4 * i4] * bflo(g.x), res[vt][4 * i4 + 1] * bfhi(g.x),
                 res[vt][4 * i4 + 2] * bflo(g.y), res[vt][4 * i4 + 3] * bfhi(g.y));
        }
    }
  }
}

template <bool SMP>
DI void run_diff(const Params& p, int b, int qb, int hd, char* smem) {
  const int tid = otid(), lane = tid & 63, w = tid >> 6, r = lane & 31, h = lane >> 5;
  const int slot = w >> 1, qh = w & 1;
  const bool active = SMP ? (qh == 0) : true;
  const bool rowvalid = SMP ? (r < 16) : true;
  const int tok = SMP ? TP + b * 16 + (r & 15) : b * 4096 + qb * 64 + qh * 32 + r;
  const u16* qptr = p.dqb() + (size_t)tok * 512 + hd * 128 + slot * 64;
  f32x16 o[4];
#pragma unroll
  for (int dt = 0; dt < 4; ++dt)
#pragma unroll
    for (int i = 0; i < 16; ++i) o[dt][i] = 0.f;
  float m = -1e30f, l = 0.f;
  constexpr int RSK = 272, RSV = 320;
  const int niter = SMP ? 65 : qb + 1;
  Stage128 st;
  constexpr int TILEB = 64 * RSK + 64 * RSV;
  auto issue = [&](int t) {
    if (!SMP) { const size_t ro = (size_t)(b * 4096 + t * 64) * 512 + hd * 128; issue128_full(st, tid, p.dkb() + ro, p.dvb() + ro, 512); }
    else if (t < 64) { const size_t ro = (size_t)(b * 2048 + t * 32) * 512 + hd * 128; issue128_f32(st, tid, p.c_dk + ro, p.c_dv + ro, 512); }
    else { const size_t ro = (size_t)(TP + b * 16) * 512 + hd * 128; issue128_bf16(st, tid, p.dkb() + ro, p.dvb() + ro, 512, 32, 16); }
  };
  auto commit = [&](int t, char* dst) {
    if (!SMP) commit128_full(st, tid, dst, RSK, dst + 64 * RSK, RSV);
    else if (t < 64) commit128_f32(st, tid, dst, RSK, dst + 64 * RSK, RSV);
    else commit128_bf16(st, tid, dst, RSK, dst + 64 * RSK, RSV, 32);
  };
  issue(0);
  bf16x8 qf[4];
#pragma unroll
  for (int kk = 0; kk < 4; ++kk) {
    bf16x8 z = {0, 0, 0, 0, 0, 0, 0, 0};
    qf[kk] = rowvalid ? *(const bf16x8*)(qptr + kk * 16 + h * 8) : z;
  }
  commit(0, smem);
#pragma unroll
  for (int kk = 0; kk < 4; ++kk) asm volatile("" : "+v"(qf[kk]));
  if (niter > 1) issue(1);
  __syncthreads();
  for (int it = 0; it < niter; ++it) {
    const char* Kc = smem + (it & 1) * TILEB; const char* Vc = Kc + 64 * RSK;
    if (active) {
      const int nhalf = SMP ? 1 : 2;
      const int nvalid = (SMP && it == 64) ? 16 : 32;
      if (nhalf == 2) {
        attn_tile64<4, 4>(Kc + slot * 128, RSK, Vc, RSV, qf, m, l, o, lane);
      } else {
        f32x16 s;
        qk_half<4>(Kc + slot * 128, RSK, qf, s, r, h);
        bf16x8 pf[2];
        softmax_half<4>(s, m, l, o, pf, nvalid, h);
        pv_half<4>(Vc, RSV, pf, o, lane);
      }
    }
    if (it + 1 < niter) {
      commit(it + 1, smem + ((it + 1) & 1) * TILEB);
      if (it + 2 < niter) issue(it + 2);
    }
    __syncthreads();
  }
  const float inv = 1.f / x32_sum(l);
  __syncthreads();
  float* buf = (float*)smem;
  const int ql = qh * 32 + r;
  if (slot == 1 && active) {
#pragma unroll
    for (int dt = 0; dt < 4; ++dt)
#pragma unroll
      for (int i = 0; i < 16; ++i) buf[ql * 132 + 32 * dt + crow(i, h)] = o[dt][i] * inv;
  }
  __syncthreads();
  if (slot == 0 && active) {
    const float lam = p.lam()[0];
    float ss = 0.f;
#pragma unroll
    for (int dt = 0; dt < 4; ++dt)
#pragma unroll
      for (int i = 0; i < 16; ++i) {
        float x = o[dt][i] * inv - lam * buf[ql * 132 + 32 * dt + crow(i, h)];
        o[dt][i] = x; ss += x * x;
      }
    ss = x32_sum(ss);
    const float rstd = rsqrtf(ss * (1.f / 128.f) + EPS) * (1.f - LAM_INIT);
    if (rowvalid) {
#pragma unroll
      for (int dt = 0; dt < 4; ++dt)
#pragma unroll
        for (int i4 = 0; i4 < 4; ++i4) {
          const int d0 = 32 * dt + 8 * i4 + 4 * h;
          uint2 g = *(const uint2*)(p.gd() + (size_t)tok * 512 + hd * 128 + d0);
          float4 sg = *(const float4*)(p.subln_g + d0);
          st_bf4(p.A2() + (size_t)tok * 1024 + 512 + hd * 128 + d0, o[dt][4 * i4] * rstd * sg.x * bflo(g.x), o[dt][4 * i4 + 1] * rstd * sg.y * bfhi(g.x),
                 o[dt][4 * i4 + 2] * rstd * sg.z * bflo(g.y), o[dt][4 * i4 + 3] * rstd * sg.w * bfhi(g.y));
        }
    }
  }
}

template <bool SMP>
DI void run_sb(const Params& p, int b, int qb, int hp, char* smem) {
  const int tid = otid(), lane = tid & 63, w = tid >> 6, r = lane & 31, h = lane >> 5;
  const int slot = w >> 1, qh = w & 1;
  const int head = 2 * hp + slot;
  const bool active = SMP ? (qh == 0) : true;
  const bool rowvalid = SMP ? (r < 16) : true;
  const int tok = SMP ? TP + b * 16 + (r & 15) : b * 4096 + qb * 64 + qh * 32 + r;
  const u16* qptr = p.sqb() + (size_t)tok * 1024 + head * 64;
  f32x16 o[2];
#pragma unroll
  for (int dt = 0; dt < 2; ++dt)
#pragma unroll
    for (int i = 0; i < 16; ++i) o[dt][i] = 0.f;
  float carry = 1.f;
  bool wdone = !active;
  constexpr int RSK = 272, RSV = 320;
  volatile int* flags = (volatile int*)(smem + SMEM_MAIN);
  const int niter = SMP ? 65 : qb + 1;
  Stage128 st;
  constexpr int TILEB = 64 * RSK + 64 * RSV;
  auto issue = [&](int t) {
    if (!SMP) { const size_t ro = (size_t)(b * 4096 + (qb - t) * 64) * 1024 + hp * 128; issue128_full(st, tid, p.skb() + ro, p.svb() + ro, 1024); }
    else if (t == 0) { const size_t ro = (size_t)(TP + b * 16) * 1024 + hp * 128; issue128_bf16(st, tid, p.skb() + ro, p.svb() + ro, 1024, 32, 16); }
    else { const size_t ro = (size_t)(b * 2048 + (64 - t) * 32) * 1024 + hp * 128; issue128_f32(st, tid, p.c_sk + ro, p.c_sv + ro, 1024); }
  };
  auto commit = [&](int t, char* dst) {
    if (!SMP) commit128_full(st, tid, dst, RSK, dst + 64 * RSK, RSV);
    else if (t == 0) commit128_bf16(st, tid, dst, RSK, dst + 64 * RSK, RSV, 32);
    else commit128_f32(st, tid, dst, RSK, dst + 64 * RSK, RSV);
  };
  issue(0);
  bf16x8 qf[4];
#pragma unroll
  for (int kk = 0; kk < 4; ++kk) {
    bf16x8 z = {0, 0, 0, 0, 0, 0, 0, 0};
    qf[kk] = rowvalid ? *(const bf16x8*)(qptr + kk * 16 + h * 8) : z;
  }
  commit(0, smem);
#pragma unroll
  for (int kk = 0; kk < 4; ++kk) asm volatile("" : "+v"(qf[kk]));
  if (niter > 1) issue(1);
  __syncthreads();
  for (int it = 0; it < niter; ++it) {
    const char* Kc = smem + (it & 1) * TILEB; const char* Vc = Kc + 64 * RSK;
    if (!wdone) {
      int limit, wlimit;
      if (SMP) { if (it == 0) { limit = r & 15; wlimit = 16; } else { limit = 32; wlimit = 32; } }
      else if (it == 0) { limit = qh * 32 + r; wlimit = qh * 32 + 32; }
      else { limit = 64; wlimit = 64; }
      for (int kt2 = (wlimit > 32 ? 1 : 0); kt2 >= 0; --kt2) {
        f32x16 s;
        qk_half<4>(Kc + slot * 128 + 32 * kt2 * RSK, RSK, qf, s, r, h);
        bf16x8 pf[2];
        if (it == 0) sb_half<true>(s, carry, pf, limit - 32 * kt2, h);
        else sb_half<false>(s, carry, pf, 32, h);
        pv_half<2>(Vc + slot * 128 + 32 * kt2 * RSV, RSV, pf, o, lane);
      }
      wdone = __all((carry < 1e-37f) || !rowvalid);
    }
    volatile int* fl = flags + 4 * (it & 1);
    if (lane == 0) fl[w] = wdone ? 1 : 0;
    if (it + 1 < niter) {
      commit(it + 1, smem + ((it + 1) & 1) * TILEB);
      if (it + 2 < niter) issue(it + 2);
    }
    __syncthreads();
    if (fl[0] && fl[1] && fl[2] && fl[3]) break;
  }
  if (active && rowvalid) {
#pragma unroll
    for (int dt = 0; dt < 2; ++dt)
#pragma unroll
      for (int i4 = 0; i4 < 4; ++i4) {
        const int d0 = 32 * dt + 8 * i4 + 4 * h;
        uint2 g = *(const uint2*)(p.sgb() + (size_t)tok * 1024 + head * 64 + d0);
        st_bf4(p.A2() + (size_t)tok * 1024 + head * 64 + d0, o[dt][4 * i4] * bflo(g.x), o[dt][4 * i4 + 1] * bfhi(g.x),
               o[dt][4 * i4 + 2] * bflo(g.y), o[dt][4 * i4 + 3] * bfhi(g.y));
      }
  }
}

struct TileSched { int t, hi, step; };
DI TileSched tile_sched(int ntot) {
  TileSched ts;
  if ((gridDim.x & 7) == 0) {
    const int xcd = blockIdx.x & 7, j = blockIdx.x >> 3, nb = gridDim.x >> 3;
    ts.t = (int)(((long)ntot * xcd) >> 3) + j; ts.hi = (int)(((long)ntot * (xcd + 1)) >> 3); ts.step = nb;
  } else { ts.t = blockIdx.x; ts.hi = ntot; ts.step = gridDim.x; }
  return ts;
}
DI int next_item_xcd(unsigned* heads, int myx, int per, char* smem) {
  volatile int* slot = (volatile int*)(smem + SMEM_MAIN + 48);
  __syncthreads();
  if (threadIdx.x == 0) {
    int item = -1;
    for (int k = 0; k < 8; ++k) {
      const int q = (myx + k) & 7;
      const unsigned v = atomicAdd(heads + 64 * q, 1u);
      if (v < (unsigned)per) { item = q * per + (int)v; break; }
    }
    *slot = item;
  }
  __syncthreads();
  return *slot;
}
DI int next_item(unsigned* ctr, char* smem) {
  volatile int* slot = (volatile int*)(smem + SMEM_MAIN + 48);
  __syncthreads();
  if (threadIdx.x == 0) *slot = (int)atomicAdd(ctr, 1u);
  __syncthreads();
  return *slot;
}

__global__ void __launch_bounds__(256, 2) fwd_megakernel(Params p) {
  __shared__ __attribute__((aligned(16))) char smem[SMEM_TOTAL];
  const int tid = threadIdx.x;
  volatile LAS unsigned* st = (volatile LAS unsigned*)(smem + SMEM_MAIN + 32);
  if (tid < 16) ((volatile int*)(smem + SMEM_MAIN))[tid] = 0;
  __syncthreads();
  XcdBarrier xb = xcd_barrier_post(p.bar(), st);
  if (p.use_cg) cg::this_grid().sync();

  phase_p0(p, smem);
  xcd_barrier(xb);
  for (TileSched ts = tile_sched(128 * 12); ts.t < ts.hi; ts.t += ts.step) {
    const int mt = ts.t / 12, n2 = ts.t % 12;
    gemm_tile_wide<1024>(p.xb(), 1024, p.Wt_in_e(), 1024, mt * 128, n2 * 256, smem, [&](int half) { epi_e1a(p, mt, 2 * n2 + half, (const float*)smem); });
  }
  for (TileSched ts = tile_sched(8 * 24); ts.t < ts.hi; ts.t += ts.step) {
    const int hm = ts.t / 24, nt = ts.t % 24;
    gemm_tile<1024, 64>(p.xb(), 1024, p.Wt_in_e(), 1024, TP + hm * 64, nt * 128, smem);
    epi_e1a(p, 128 + (hm >> 1), nt, (const float*)smem, (hm & 1) * 64, 8);
  }
  xcd_barrier(xb);
  for (TileSched ts = tile_sched(MT * 10); ts.t < ts.hi; ts.t += ts.step) {
    const int t = ts.t;
    const int mt = t / 10, nt = t % 10;
    gemm_tile<256>(p.qlat(), 256, p.Wc(), 256, mt * 128, nt * 128, smem);
    epi_e1b(p, mt, nt, (const float*)smem);
  }
  xcd_barrier(xb);
  for (int rep = 0; rep < (REP == 2 ? 2 : 1); ++rep)
  for (;;) {
    const int item = next_item_xcd(p.bar() + (rep ? XB_XQ2(0) : XB_XQ(0)), (int)(xb.x & 7u), 276, smem);
    if (item < 0) break;
    const int q = item / 276, v = item % 276;
    if (v < 4) run_mla<true>(p, 4 * q + v, 0, 0, smem);
    else if (v < 20) { const int idx = 16 * q + (v - 4); run_diff<true>(p, idx >> 2, 0, idx & 3, smem); }
    else {
      const int j = v - 20, qb = 63 - (j >> 2), k = j & 3;
      if (k < 2) run_mla<false>(p, q >> 1, qb, 2 * (q & 1) + k, smem);
      else { const int pr = 2 * q + (k - 2); run_diff<false>(p, pr >> 2, qb, pr & 3, smem); }
    }
  }
  xcd_barrier(xb);
  for (TileSched ts = tile_sched(128 * 4); ts.t < ts.hi; ts.t += ts.step) {
    const int mt = ts.t >> 2, n2 = ts.t & 3;
    gemm_tile_wide<1024>(p.A2(), 1024, p.Wt_out_e(), 1024, mt * 128, n2 * 256, smem, [&](int half) { epi_out(p, mt, 2 * n2 + half, (const float*)smem, 0); });
  }
  for (TileSched ts = tile_sched(64); ts.t < ts.hi; ts.t += ts.step) {
    const int hm = ts.t >> 3, nt = ts.t & 7;
    gemm_tile<1024, 64>(p.A2(), 1024, p.Wt_out_e(), 1024, TP + hm * 64, nt * 128, smem);
    epi_out(p, 128 + (hm >> 1), nt, (const float*)smem, 0, (hm & 1) * 64, 8);
  }
  xcd_barrier(xb);
  phase_ln(p, 0);
  xcd_barrier(xb);
  for (TileSched ts = tile_sched(128 * 16); ts.t < ts.hi; ts.t += ts.step) {
    const int mt = ts.t >> 4, n2 = ts.t & 15;
    gemm_tile_wide<1024>(p.y0b(), 1024, p.Wt_in_o(), 1024, mt * 128, n2 * 256, smem, [&](int half) { epi_o1(p, mt, 2 * n2 + half, (const float*)smem); });
  }
  for (TileSched ts = tile_sched(8 * 32); ts.t < ts.hi; ts.t += ts.step) {
    const int hm = ts.t >> 5, nt = ts.t & 31;
    gemm_tile<1024, 64>(p.y0b(), 1024, p.Wt_in_o(), 1024, TP + hm * 64, nt * 128, smem);
    epi_o1(p, 128 + (hm >> 1), nt, (const float*)smem, (hm & 1) * 64, 8);
  }
  xcd_barrier(xb);
  for (int rep = 0; rep < (REP == 3 ? 2 : 1); ++rep)
  for (;;) {
    const int item = next_item(p.bar() + (rep ? XB_CTR3 : XB_CTR1), smem);
    if (item >= 2304) break;
    if (item < 256) run_sb<true>(p, item >> 3, 0, item & 7, smem);
    else { const int j = item - 256; run_sb<false>(p, (j >> 3) & 3, 63 - (j >> 5), j & 7, smem); }
  }
  xcd_barrier(xb);
  for (TileSched ts = tile_sched(128 * 4); ts.t < ts.hi; ts.t += ts.step) {
    const int mt = ts.t >> 2, n2 = ts.t & 3;
    gemm_tile_wide<1024>(p.A2(), 1024, p.Wt_out_o(), 1024, mt * 128, n2 * 256, smem, [&](int half) { epi_out(p, mt, 2 * n2 + half, (const float*)smem, 1); });
  }
  for (TileSched ts = tile_sched(64); ts.t < ts.hi; ts.t += ts.step) {
    const int hm = ts.t >> 3, nt = ts.t & 7;
    gemm_tile<1024, 64>(p.A2(), 1024, p.Wt_out_o(), 1024, TP + hm * 64, nt * 128, smem);
    epi_out(p, 128 + (hm >> 1), nt, (const float*)smem, 1, (hm & 1) * 64, 8);
  }
  xcd_barrier(xb);
  phase_ln(p, 1);
}

extern "C" void kernel_launch(void* const* d_in, const int* in_sizes, int n_in, void* d_out, int out_size, void* d_ws, size_t ws_size,
                              hipStream_t stream) {
  static int grid_blocks = 0;
  if (!grid_blocks) {
    int dev = 0, cus = 0, per_cu = 0;
    (void)hipGetDevice(&dev);
    (void)hipDeviceGetAttribute(&cus, hipDeviceAttributeMultiprocessorCount, dev);
    (void)hipOccupancyMaxActiveBlocksPerMultiprocessor(&per_cu, fwd_megakernel, 256, 0);
    if (per_cu > 2) per_cu = 2;
    if (per_cu < 1) per_cu = 1;
    grid_blocks = cus * per_cu;
  }
  Params p;
  memset(&p, 0, sizeof(p));
  const float* const* in = (const float* const*)d_in;
  p.x_prompt = in[0]; p.x_sample = in[1]; p.c_ckv = in[2]; p.c_krope = in[3]; p.c_dk = in[4]; p.c_dv = in[5]; p.c_sk = in[6]; p.c_sv = in[7];
  p.w_in_even = in[8]; p.q_g = in[9]; p.w_uq = in[10]; p.kv_g = in[11]; p.w_uk = in[12]; p.w_uv = in[13]; p.lam_q = in[14]; p.lam_k = in[15];
  p.subln_g = in[16]; p.w_out_even = in[17]; p.ln_e_g = in[18]; p.ln_e_b = in[19]; p.w_in_odd = in[20]; p.w_out_odd = in[21]; p.ln_o_g = in[22]; p.ln_o_b = in[23];
  p.out = (float*)d_out;
  p.ws = (char*)d_ws;
  const size_t off = WS_END;
  p.use_cg = 0;
  if (off > ws_size) { fprintf(stderr, "workspace too small: need %zu have %zu\n", off, ws_size); return; }
  (void)hipMemsetAsync(d_ws, 0, BAR_BYTES, stream);
  void* args[] = {&p};
  hipError_t e = hipLaunchCooperativeKernel((void*)fwd_megakernel, dim3(grid_blocks), dim3(256), args, 0, stream);
  if (e != hipSuccess) fprintf(stderr, "cooperative launch failed: %s (grid %d)\n", hipGetErrorString(e), grid_blocks);
}
```

```cpp
#include <hip/hip_runtime.h>
#include <hip/hip_cooperative_groups.h>
#include <stdint.h>
#include <stdio.h>
#include <string.h>
namespace cg = cooperative_groups;

typedef unsigned short u16;
using bf16x8 = __attribute__((ext_vector_type(8))) short;
using s16x4  = __attribute__((ext_vector_type(4))) short;
using f32x16 = __attribute__((ext_vector_type(16))) float;
using u32x4  = __attribute__((ext_vector_type(4))) unsigned;
using f32x4  = __attribute__((ext_vector_type(4))) float;
typedef __attribute__((ext_vector_type(2))) __bf16 bf2_t;
#define DI __device__ __forceinline__
#define LAS __attribute__((address_space(3)))
#define MFMA(a, b, c) __builtin_amdgcn_mfma_f32_32x32x16_bf16((a), (b), (c), 0, 0, 0)

constexpr int TP = 16384;
constexpr int TS = 512;
constexpr int T  = TP + TS;
constexpr int MT = T / 128;
constexpr float EPS = 1e-5f;
constexpr float ALPHA = 1.4142135623730951f;
constexpr float LOG2E = 1.4426950408889634f;
constexpr float QS_MLA = 0.10206207261596577f * LOG2E;
constexpr float QS_64  = 0.125f * LOG2E;
constexpr float LAM_INIT = 0.2f;

constexpr size_t OFF_YP = 0, OFF_YS = 16777216, OFF_CKV_P = 17301504, OFF_KR_P = 19398656, OFF_DK_P = 19922944,
                 OFF_DV_P = 28311552, OFF_SK_P = 36700160, OFF_SV_P = 53477376, OFF_CKV_S = 70254592, OFF_KR_S = 70320128,
                 OFF_DK_S = 70336512, OFF_DV_S = 70598656, OFF_SK_S = 70860800, OFF_SV_S = 71385088;

constexpr int SMEM_MAIN = 75776;
constexpr int SMEM_TOTAL = SMEM_MAIN + 64;

#define BAR_BYTES   32768
constexpr size_t al256(size_t x) { return (x + 255) & ~(size_t)255; }
constexpr size_t WS_bar = 0;
constexpr size_t WS_xb = WS_bar + al256(BAR_BYTES);
constexpr size_t WS_Wt_in_e = WS_xb + al256((size_t)T*1024*2);
constexpr size_t WS_Wc = WS_Wt_in_e + al256((size_t)3072*1024*2);
constexpr size_t WS_Wt_uv = WS_Wc + al256((size_t)1280*256*2);
constexpr size_t WS_Wt_out_e = WS_Wt_uv + al256((size_t)512*128*2);
constexpr size_t WS_Wt_in_o = WS_Wt_out_e + al256((size_t)1024*1024*2);
constexpr size_t WS_Wt_out_o = WS_Wt_in_o + al256((size_t)4096*1024*2);
constexpr size_t WS_qlat = WS_Wt_out_o + al256((size_t)1024*1024*2);
constexpr size_t WS_Kmla = WS_qlat + al256((size_t)T*256*2);
constexpr size_t WS_gm = WS_Kmla + al256((size_t)T*160*2);
constexpr size_t WS_dqb = WS_gm + al256((size_t)T*512*2);
constexpr size_t WS_dkb = WS_dqb + al256((size_t)T*512*2);
constexpr size_t WS_dvb = WS_dkb + al256((size_t)T*512*2);
constexpr size_t WS_gd = WS_dvb + al256((size_t)T*512*2);
constexpr size_t WS_Qmla = WS_gd + al256((size_t)T*512*2);
constexpr size_t WS_A2 = WS_Qmla + al256((size_t)T*1280*2);
constexpr size_t WS_y0b = WS_A2 + al256((size_t)T*1024*2);
constexpr size_t WS_sqb = WS_y0b + al256((size_t)T*1024*2);
constexpr size_t WS_skb = WS_sqb + al256((size_t)T*1024*2);
constexpr size_t WS_svb = WS_skb + al256((size_t)T*1024*2);
constexpr size_t WS_sgb = WS_svb + al256((size_t)T*1024*2);
constexpr size_t WS_ssq = WS_sgb + al256((size_t)T*1024*2);
constexpr size_t WS_pre = WS_ssq + al256((size_t)T*2*4);
constexpr size_t WS_y0f = WS_pre + al256((size_t)T*1024*4);
constexpr size_t WS_ropeC = WS_y0f + al256((size_t)T*1024*4);
constexpr size_t WS_ropeS = WS_ropeC + al256((size_t)4096*24*4);
constexpr size_t WS_lam = WS_ropeS + al256((size_t)4096*24*4);
constexpr size_t WS_END = WS_lam + al256(256);
struct Params {
  const float *x_prompt, *x_sample, *c_ckv, *c_krope, *c_dk, *c_dv, *c_sk, *c_sv;
  const float *w_in_even, *q_g, *w_uq, *kv_g, *w_uk, *w_uv, *lam_q, *lam_k, *subln_g, *w_out_even, *ln_e_g, *ln_e_b;
  const float *w_in_odd, *w_out_odd, *ln_o_g, *ln_o_b;
  float* out;
  char* ws;
  int use_cg; int pad_;
  DI unsigned* bar() const { return (unsigned*)(ws + WS_bar); }
  DI u16* xb() const { return (u16*)(ws + WS_xb); }
  DI u16* Wt_in_e() const { return (u16*)(ws + WS_Wt_in_e); }
  DI u16* Wc() const { return (u16*)(ws + WS_Wc); }
  DI u16* Wt_uv() const { return (u16*)(ws + WS_Wt_uv); }
  DI u16* Wt_out_e() const { return (u16*)(ws + WS_Wt_out_e); }
  DI u16* Wt_in_o() const { return (u16*)(ws + WS_Wt_in_o); }
  DI u16* Wt_out_o() const { return (u16*)(ws + WS_Wt_out_o); }
  DI u16* qlat() const { return (u16*)(ws + WS_qlat); }
  DI u16* Kmla() const { return (u16*)(ws + WS_Kmla); }
  DI u16* gm() const { return (u16*)(ws + WS_gm); }
  DI u16* dqb() const { return (u16*)(ws + WS_dqb); }
  DI u16* dkb() const { return (u16*)(ws + WS_dkb); }
  DI u16* dvb() const { return (u16*)(ws + WS_dvb); }
  DI u16* gd() const { return (u16*)(ws + WS_gd); }
  DI u16* Qmla() const { return (u16*)(ws + WS_Qmla); }
  DI u16* A2() const { return (u16*)(ws + WS_A2); }
  DI u16* y0b() const { return (u16*)(ws + WS_y0b); }
  DI u16* sqb() const { return (u16*)(ws + WS_sqb); }
  DI u16* skb() const { return (u16*)(ws + WS_skb); }
  DI u16* svb() const { return (u16*)(ws + WS_svb); }
  DI u16* sgb() const { return (u16*)(ws + WS_sgb); }
  DI float* ssq() const { return (float*)(ws + WS_ssq); }
  DI float* pre() const { return (float*)(ws + WS_pre); }
  DI float* y0f() const { return (float*)(ws + WS_y0f); }
  DI float* ropeC() const { return (float*)(ws + WS_ropeC); }
  DI float* ropeS() const { return (float*)(ws + WS_ropeS); }
  DI float* lam() const { return (float*)(ws + WS_lam); }
};

DI unsigned pk2(float a, float b) { bf2_t v; v[0] = (__bf16)a; v[1] = (__bf16)b; return __builtin_bit_cast(unsigned, v); }
DI float bf2f(u16 v) { return __uint_as_float(((unsigned)v) << 16); }
DI float bflo(unsigned v) { return __uint_as_float(v << 16); }
DI float bfhi(unsigned v) { return __uint_as_float(v & 0xffff0000u); }
DI bf16x8 pack8(float a0, float a1, float a2, float a3, float a4, float a5, float a6, float a7) {
  u32x4 p; p[0] = pk2(a0, a1); p[1] = pk2(a2, a3); p[2] = pk2(a4, a5); p[3] = pk2(a6, a7);
  return __builtin_bit_cast(bf16x8, p);
}
DI uint2 pack4(float a0, float a1, float a2, float a3) { return make_uint2(pk2(a0, a1), pk2(a2, a3)); }
DI float x32_max(float x) { auto r = __builtin_amdgcn_permlane32_swap(__float_as_uint(x), __float_as_uint(x), false, false); return fmaxf(__uint_as_float(r[0]), __uint_as_float(r[1])); }
DI float x32_sum(float x) { auto r = __builtin_amdgcn_permlane32_swap(__float_as_uint(x), __float_as_uint(x), false, false); return __uint_as_float(r[0]) + __uint_as_float(r[1]); }
DI float x32_other(float x, int h) { auto r = __builtin_amdgcn_permlane32_swap(__float_as_uint(x), __float_as_uint(x), false, false); return __uint_as_float(h ? r[0] : r[1]); }
DI int otid() { int t = threadIdx.x; asm volatile("" : "+v"(t)); return t; }
DI float silu(float x) { return x * __builtin_amdgcn_rcpf(1.f + __expf(-x)); }
DI int crow(int reg, int h) { return (reg & 3) + 8 * (reg >> 2) + 4 * h; }
DI float ex2(float x) { return __builtin_amdgcn_exp2f(x); }
DI float lg2(float x) { return __builtin_amdgcn_logf(x); }

#define XB_TMO      128
#define XB_XCNT(j)  (256  + 64 * (j))
#define XB_XSUB(j)  (1280 + 64 * (j))
#define XB_XGEN(j)  (2304 + 64 * (j))
#define XB_TOP      3328
#define XB_TOPGEN   3392
#define XCD_BAR_WORDS 3456
#define XB_CTR0     3520
#define XB_CTR1     3584
#define XB_CTR2     3648
#define XB_CTR3     3712
#define XB_XQ(j)    (4096 + 64 * (j))
#define XB_XQ2(j)   (4608 + 64 * (j))
#ifndef REP
#define REP 0
#endif
#define XB_SPIN_CAP (1u << 24)
DI unsigned xb_ld(unsigned* p)              { return __hip_atomic_load(p, __ATOMIC_RELAXED, __HIP_MEMORY_SCOPE_AGENT); }
DI unsigned xb_add(unsigned* p, unsigned v) { return __hip_atomic_fetch_add(p, v, __ATOMIC_RELAXED, __HIP_MEMORY_SCOPE_AGENT); }
DI unsigned xb_xcc_id() { return (unsigned)__builtin_amdgcn_s_getreg((3 << 11) | 20) & 0xFu; }
#define XB_SPIN(cond, bar) do { unsigned _sp = 0; while (cond) { __builtin_amdgcn_s_sleep(1); \
    if ((++_sp & 255u) == 0u) { if (xb_ld(&(bar)[XB_TMO])) break; if (_sp > XB_SPIN_CAP) { atomicAdd(&(bar)[XB_TMO], 1u); break; } } } } while (0)
struct XcdBarrier { unsigned* bar; unsigned x; volatile LAS unsigned* st; };
DI XcdBarrier xcd_barrier_post(unsigned* bar, volatile LAS unsigned* st) {
  XcdBarrier b; b.bar = bar; b.x = xb_xcc_id(); b.st = st;
  if (threadIdx.x == 0) (void)xb_add(&bar[XB_XCNT(b.x)], 1u);
  return b;
}
DI void xcd_barrier_complete(unsigned* bar, unsigned x, unsigned& nloc, unsigned& nx) {
  const unsigned G = gridDim.x * gridDim.y * gridDim.z;
  unsigned sum, cnt, mine, sp = 0u;
  for (;;) {
    sum = 0u; cnt = 0u; mine = 0u;
#pragma unroll
    for (unsigned j = 0; j < 16; ++j) { const unsigned c = xb_ld(&bar[XB_XCNT(j)]); sum += c; cnt += (c > 0u) ? 1u : 0u; mine = (j == x) ? c : mine; }
    if (sum == G) break;
    __builtin_amdgcn_s_sleep(1);
    if ((++sp & 255u) == 0u) { if (xb_ld(&bar[XB_TMO])) break; if (sp > XB_SPIN_CAP) { atomicAdd(&bar[XB_TMO], 1u); break; } }
  }
  nloc = mine > 0u ? mine : 1u; nx = cnt > 0u ? cnt : 1u;
}
DI void xcd_barrier(const XcdBarrier& b) {
  asm volatile("s_waitcnt vmcnt(0)" ::: "memory");
  __syncthreads();
  if (threadIdx.x == 0) {
    unsigned* bar = b.bar;
    __builtin_amdgcn_s_waitcnt(0);
    unsigned nloc = b.st[0], nx = b.st[1];
    if (nloc == 0u) { xcd_barrier_complete(bar, b.x, nloc, nx); b.st[0] = nloc; b.st[1] = nx; }
    const unsigned old = xb_add(&bar[XB_XSUB(b.x)], 1u);
    const unsigned gen = old / nloc;
    if (old + 1u == (gen + 1u) * nloc) {
      __builtin_amdgcn_fence(__ATOMIC_RELEASE, "agent");
      asm volatile("s_waitcnt vmcnt(0)" ::: "memory");
      const unsigned og = xb_add(&bar[XB_TOP], 1u);
      const unsigned tg = og / nx;
      if (og + 1u == (tg + 1u) * nx) xb_add(&bar[XB_TOPGEN], 1u);
      else XB_SPIN(xb_ld(&bar[XB_TOPGEN]) == tg, bar);
      __builtin_amdgcn_fence(__ATOMIC_ACQUIRE, "agent");
      xb_add(&bar[XB_XGEN(b.x)], 1u);
      asm volatile("s_waitcnt vmcnt(0)" ::: "memory");
    } else {
      XB_SPIN(xb_ld(&bar[XB_XGEN(b.x)]) == gen, bar);
      __builtin_amdgcn_fence(__ATOMIC_ACQUIRE, "agent");
      asm volatile("s_waitcnt vmcnt(0)" ::: "memory");
    }
  }
  __syncthreads();
}

constexpr int CS_LD = 132;
template <int K, int BM = 128>
DI void gemm_tile(const u16* __restrict__ A, int lda, const u16* __restrict__ Bt, int ldb, int m0, int n0, char* smem) {
  const int tid = otid(), lane = tid & 63, w = tid >> 6, r = lane & 31, h = lane >> 5;
  const int wm = w >> 1, wn = w & 1;
  constexpr int IM = BM / 64;
  constexpr int NA = BM / 32;
  f32x16 acc[IM][2];
#pragma unroll
  for (int i = 0; i < IM; ++i)
#pragma unroll
    for (int j = 0; j < 2; ++j)
#pragma unroll
      for (int e = 0; e < 16; ++e) acc[i][j][e] = 0.f;
  constexpr int NK = K / 64;
  constexpr int OPB = 128 * 128;
  constexpr int BUFB = 2 * OPB;
  const int lrow = tid >> 3, cpos = tid & 7;
  const u16* ap[4]; const u16* bp[4];
#pragma unroll
  for (int i = 0; i < 4; ++i) {
    const int row = lrow + 32 * i;
    const int sc = cpos ^ ((row >> 1) & 7);
    ap[i] = A + (size_t)(m0 + (i < NA ? row : 0)) * lda + sc * 8;
    bp[i] = Bt + (size_t)(n0 + row) * ldb + sc * 8;
  }
  char* const ldst = smem + tid * 16;
  __syncthreads();
#pragma unroll
  for (int i = 0; i < 4; ++i) {
    if (i < NA) __builtin_amdgcn_global_load_lds((const unsigned*)(ap[i]), (unsigned*)(ldst + i * 4096), 16, 0, 0);
    __builtin_amdgcn_global_load_lds((const unsigned*)(bp[i]), (unsigned*)(ldst + OPB + i * 4096), 16, 0, 0);
  }
  int aoff[2], boff[2], aswz[2], bswz[2];
#pragma unroll
  for (int i = 0; i < 2; ++i) {
    const int ra_ = wm * (BM / 2) + (i < IM ? i : 0) * 32 + r, rb_ = wn * 64 + i * 32 + r;
    aoff[i] = ra_ * 128; aswz[i] = (ra_ >> 1) & 7;
    boff[i] = rb_ * 128; bswz[i] = (rb_ >> 1) & 7;
  }
  for (int kt = 0; kt < NK; ++kt) {
    asm volatile("s_waitcnt vmcnt(0)" ::: "memory");
    __syncthreads();
    const int cur = (kt & 1) * BUFB, nxt = BUFB - cur;
    if (kt + 1 < NK) {
#pragma unroll
      for (int i = 0; i < 4; ++i) {
        if (i < NA) __builtin_amdgcn_global_load_lds((const unsigned*)(ap[i] + (kt + 1) * 64), (unsigned*)(ldst + nxt + i * 4096), 16, 0, 0);
        __builtin_amdgcn_global_load_lds((const unsigned*)(bp[i] + (kt + 1) * 64), (unsigned*)(ldst + nxt + OPB + i * 4096), 16, 0, 0);
      }
    }
    const char* As = smem + cur; const char* Bs = smem + cur + OPB;
    bf16x8 a[4][IM], b[4][2];
#pragma unroll
    for (int kk = 0; kk < 4; ++kk)
#pragma unroll
      for (int i = 0; i < 2; ++i) {
        if (i < IM) a[kk][i] = *(const bf16x8*)(As + aoff[i] + (((2 * kk + h) ^ aswz[i]) << 4));
        b[kk][i] = *(const bf16x8*)(Bs + boff[i] + (((2 * kk + h) ^ bswz[i]) << 4));
      }
    __builtin_amdgcn_sched_barrier(0);
    __builtin_amdgcn_s_setprio(1);
#pragma unroll
    for (int kk = 0; kk < 4; ++kk)
#pragma unroll
      for (int i = 0; i < IM; ++i)
#pragma unroll
        for (int j = 0; j < 2; ++j) acc[i][j] = MFMA(a[kk][i], b[kk][j], acc[i][j]);
    __builtin_amdgcn_s_setprio(0);
  }
  __syncthreads();
  float* Cs = (float*)smem;
#pragma unroll
  for (int i = 0; i < IM; ++i)
#pragma unroll
    for (int j = 0; j < 2; ++j)
#pragma unroll
      for (int e = 0; e < 16; ++e) Cs[(wm * (BM / 2) + i * 32 + crow(e, h)) * CS_LD + wn * 64 + j * 32 + r] = acc[i][j][e];
  __syncthreads();
}

template <int K, typename Epi>
DI void gemm_tile_wide(const u16* __restrict__ A, int lda, const u16* __restrict__ Bt, int ldb, int m0, int n0, char* smem, Epi epi) {
  const int tid = otid(), lane = tid & 63, w = tid >> 6, r = lane & 31, h = lane >> 5;
  const int wm = w >> 1, wn = w & 1;
  f32x16 acc[2][4];
#pragma unroll
  for (int i = 0; i < 2; ++i)
#pragma unroll
    for (int j = 0; j < 4; ++j)
#pragma unroll
      for (int e = 0; e < 16; ++e) acc[i][j][e] = 0.f;
  constexpr int NS = K / 32;
  constexpr int AB = 128 * 64;
  constexpr int STB = AB + 256 * 64;
  const int lrow = tid >> 2, cpos = tid & 3;
  const u16* ap[2]; const u16* bp[4];
#pragma unroll
  for (int i = 0; i < 4; ++i) {
    const int row = lrow + 64 * i;
    const int sc = cpos ^ ((row >> 2) & 3);
    if (i < 2) ap[i] = A + (size_t)(m0 + row) * lda + sc * 8;
    bp[i] = Bt + (size_t)(n0 + row) * ldb + sc * 8;
  }
  char* const ldst = smem + tid * 16;
  int aoff[2][2], boff[4][2];
#pragma unroll
  for (int kk = 0; kk < 2; ++kk) {
#pragma unroll
    for (int i = 0; i < 2; ++i) { const int ra_ = wm * 64 + i * 32 + r; aoff[i][kk] = ra_ * 64 + (((2 * kk + h) ^ ((ra_ >> 2) & 3)) << 4); }
#pragma unroll
    for (int j = 0; j < 4; ++j) { const int rb_ = wn * 128 + j * 32 + r; boff[j][kk] = AB + rb_ * 64 + (((2 * kk + h) ^ ((rb_ >> 2) & 3)) << 4); }
  }
  auto issue = [&](int slice, int st) {
#pragma unroll
    for (int i = 0; i < 4; ++i) {
      if (i < 2) __builtin_amdgcn_global_load_lds((const unsigned*)(ap[i] + slice * 32), (unsigned*)(ldst + st + i * 4096), 16, 0, 0);
      __builtin_amdgcn_global_load_lds((const unsigned*)(bp[i] + slice * 32), (unsigned*)(ldst + st + AB + i * 4096), 16, 0, 0);
    }
  };
  __syncthreads();
  issue(0, 0);
  for (int kt = 0; kt < NS; ++kt) {
    asm volatile("s_waitcnt vmcnt(0)" ::: "memory");
    __syncthreads();
    const int cur = (kt & 1) * STB;
    if (kt + 1 < NS) issue(kt + 1, STB - cur);
    const char* Sg = smem + cur;
    bf16x8 a[2][2], b[2][4];
#pragma unroll
    for (int kk = 0; kk < 2; ++kk) {
#pragma unroll
      for (int i = 0; i < 2; ++i) a[kk][i] = *(const bf16x8*)(Sg + aoff[i][kk]);
#pragma unroll
      for (int j = 0; j < 4; ++j) b[kk][j] = *(const bf16x8*)(Sg + boff[j][kk]);
    }
    __builtin_amdgcn_sched_barrier(0);
    __builtin_amdgcn_s_setprio(1);
#pragma unroll
    for (int kk = 0; kk < 2; ++kk)
#pragma unroll
      for (int i = 0; i < 2; ++i)
#pragma unroll
        for (int j = 0; j < 4; ++j) acc[i][j] = MFMA(a[kk][i], b[kk][j], acc[i][j]);
    __builtin_amdgcn_s_setprio(0);
  }
  float* Cs = (float*)smem;
#pragma unroll
  for (int half = 0; half < 2; ++half) {
    __syncthreads();
    if (wn == half) {
#pragma unroll
      for (int i = 0; i < 2; ++i)
#pragma unroll
        for (int j = 0; j < 4; ++j)
#pragma unroll
          for (int e = 0; e < 16; ++e) Cs[(wm * 64 + i * 32 + crow(e, h)) * CS_LD + j * 32 + r] = acc[i][j][e];
    }
    __syncthreads();
    epi(half);
  }
}

DI float half_sum(float v) {
  v += __shfl_xor(v, 16); v += __shfl_xor(v, 8); v += __shfl_xor(v, 4); v += __shfl_xor(v, 2); v += __shfl_xor(v, 1);
  return v;
}
DI float wave_sum(float v) { v = half_sum(v); v += __shfl_xor(v, 32); return v; }

DI void transpose_tile(const float* __restrict__ src, int N, int Kdim, int k0, int n0, u16* __restrict__ dst, int remap, char* smem) {
  float* tl = (float*)smem;
  const int tid = otid();
  __syncthreads();
#pragma unroll
  for (int i = 0; i < 4; ++i) {
    const int kr = i * 16 + (tid >> 4), nc = (tid & 15) * 4;
    f32x4 v = {0.f, 0.f, 0.f, 0.f};
    if (n0 + nc < N) v = __builtin_nontemporal_load((const f32x4*)(src + (size_t)(k0 + kr) * N + n0 + nc));
    tl[(nc + 0) * 65 + kr] = v[0]; tl[(nc + 1) * 65 + kr] = v[1]; tl[(nc + 2) * 65 + kr] = v[2]; tl[(nc + 3) * 65 + kr] = v[3];
  }
  __syncthreads();
  int nr = tid >> 2, kc = (tid & 3) * 16;
  int n = n0 + nr;
  if (n < N) {
    int nrow = remap ? (n < 416 ? n : n + 96) : n;
    float v[16];
#pragma unroll
    for (int e = 0; e < 16; ++e) v[e] = tl[nr * 65 + kc + e];
    uint4 a, b;
    a.x = pk2(v[0], v[1]); a.y = pk2(v[2], v[3]); a.z = pk2(v[4], v[5]); a.w = pk2(v[6], v[7]);
    b.x = pk2(v[8], v[9]); b.y = pk2(v[10], v[11]); b.z = pk2(v[12], v[13]); b.w = pk2(v[14], v[15]);
    u16* d = dst + (size_t)nrow * Kdim + k0 + kc;
    *(uint4*)d = a; *(uint4*)(d + 8) = b;
  }
}

DI void phase_p0(const Params& p, char* smem) {
  const int tid = otid();
  const size_t gtid = (size_t)blockIdx.x * 256 + tid, gsz = (size_t)gridDim.x * 256;
  for (size_t i = gtid; i < (size_t)T * 128; i += gsz) {
    size_t tok = i >> 7; int c = (int)(i & 127) * 8;
    const float* s = tok < TP ? p.x_prompt + tok * 1024 + c : p.x_sample + (tok - TP) * 1024 + c;
    const f32x4 a = __builtin_nontemporal_load((const f32x4*)s), b = __builtin_nontemporal_load((const f32x4*)(s + 4));
    uint4 o; o.x = pk2(a[0], a[1]); o.y = pk2(a[2], a[3]); o.z = pk2(b[0], b[1]); o.w = pk2(b[2], b[3]);
    *(uint4*)(p.xb() + tok * 1024 + c) = o;
  }
  constexpr int NA = 16 * 47, NB = 2 * 8, NC = 256, ND = 1024, NE = 256;
  for (int j = blockIdx.x; j < NA + NB + NC + ND + NE; j += gridDim.x) {
    if (j < NA) transpose_tile(p.w_in_even, 2976, 1024, (j / 47) * 64, (j % 47) * 64, p.Wt_in_e(), 1, smem);
    else if (j < NA + NB) { int q = j - NA; transpose_tile(p.w_uv, 512, 128, (q / 8) * 64, (q % 8) * 64, p.Wt_uv(), 0, smem); }
    else if (j < NA + NB + NC) { int q = j - NA - NB; transpose_tile(p.w_out_even, 1024, 1024, (q / 16) * 64, (q % 16) * 64, p.Wt_out_e(), 0, smem); }
    else if (j < NA + NB + NC + ND) { int q = j - NA - NB - NC; transpose_tile(p.w_in_odd, 4096, 1024, (q / 64) * 64, (q % 64) * 64, p.Wt_in_o(), 0, smem); }
    else { int q = j - NA - NB - NC - ND; transpose_tile(p.w_out_odd, 1024, 1024, (q / 16) * 64, (q % 16) * 64, p.Wt_out_o(), 0, smem); }
  }
  for (size_t i = gtid; i < (size_t)96 * 128; i += gsz) *(uint4*)(p.Wt_in_e() + (size_t)416 * 1024 + i * 8) = make_uint4(0, 0, 0, 0);
  for (size_t i = gtid; i < (size_t)1280 * 256; i += gsz) {
    int o = (int)(i >> 8), l = (int)(i & 255);
    int hh = o / 160, c = o % 160;
    float g = p.q_g[l];
    float acc;
    if (c < 128) {
      const float* a = p.w_uq + (size_t)l * 768 + hh * 96;
      const float* b = p.w_uk + (size_t)c * 512 + hh * 64;
      acc = 0.f;
#pragma unroll
      for (int n = 0; n < 64; n += 4) {
        const float4 av = *(const float4*)(a + n), bv = *(const float4*)(b + n);
        acc += av.x * bv.x; acc += av.y * bv.y; acc += av.z * bv.z; acc += av.w * bv.w;
      }
    } else {
      acc = p.w_uq[(size_t)l * 768 + hh * 96 + 64 + (c - 128)];
    }
    bf2_t v; v[0] = (__bf16)(acc * g * QS_MLA); v[1] = v[0];
    p.Wc()[i] = (u16)(__builtin_bit_cast(unsigned, v) & 0xffffu);
  }
  for (size_t i = gtid; i < (size_t)4096 * 24; i += gsz) {
    int pos = (int)(i / 24), j = (int)(i % 24);
    float t;
    if (j < 16) { t = (-9.210340371976184f) * (float)j; t = t * 0.0625f; }
    else { t = (-13.122363377404328f) * (float)(j - 16); t = t * 0.125f; }
    float inv = expf(t);
    float ang = (float)pos * inv;
    p.ropeC()[i] = cosf(ang); p.ropeS()[i] = sinf(ang);
  }
  if (gtid == 0) {
    float s0 = 0.f, s1 = 0.f;
    for (int d = 0; d < 64; ++d) { s0 += p.lam_q[d] * p.lam_k[d]; s1 += p.lam_q[64 + d] * p.lam_k[64 + d]; }
    p.lam()[0] = expf(s0) - expf(s1) + LAM_INIT;
  }
}

DI void st_nt4(float* d, float4 v) {
  f32x4 t = {v.x, v.y, v.z, v.w};
  __builtin_nontemporal_store(t, (f32x4*)d);
}
DI void st_bf4(u16* d, float a, float b, float c, float e) { *(uint2*)d = pack4(a, b, c, e); }

DI void epi_e1a(const Params& p, int mt, int nt, const float* Cs, int row0 = 0, int npass = 16) {
  const int tid = otid(), c4 = (tid & 31) * 4;
  for (int pp = 0; pp < npass; ++pp) {
    const int row = pp * 8 + (tid >> 5);
    const int tok = mt * 128 + row0 + row;
    const bool smp = tok >= TP;
    const int pos = smp ? 2048 + ((tok - TP) & 15) : (tok & 4095);
    const float* cr = Cs + row * CS_LD;
    float4 v = *(const float4*)(cr + c4);
    if (nt < 2) {
      st_bf4(p.qlat() + (size_t)tok * 256 + nt * 128 + c4, v.x, v.y, v.z, v.w);
      float ss = half_sum(v.x * v.x + v.y * v.y + v.z * v.z + v.w * v.w);
      if ((tid & 31) == 0) p.ssq()[tok * 2 + nt] = ss;
    } else if (nt == 2) {
      float ss = half_sum(v.x * v.x + v.y * v.y + v.z * v.z + v.w * v.w);
      float rstd = rsqrtf(ss * (1.f / 128.f) + EPS);
      float4 g = *(const float4*)(p.kv_g + c4);
      float4 o = make_float4(v.x * rstd * g.x, v.y * rstd * g.y, v.z * rstd * g.z, v.w * rstd * g.w);
      float* d = smp ? p.out + OFF_CKV_S + (size_t)(tok - TP) * 128 + c4 : p.out + OFF_CKV_P + (size_t)tok * 128 + c4;
      st_nt4(d, o);
      st_bf4(p.Kmla() + (size_t)tok * 160 + c4, o.x, o.y, o.z, o.w);
    } else if (nt == 3) {
      if (c4 < 32) {
        const bool second = c4 >= 16; const int i0 = c4 & 15;
        float o[4];
#pragma unroll
        for (int e = 0; e < 4; ++e) {
          int i = i0 + e;
          float x1 = cr[i], x2 = cr[i + 16];
          float cs = p.ropeC()[pos * 24 + i], sn = p.ropeS()[pos * 24 + i];
          o[e] = second ? (x1 * sn + x2 * cs) : (x1 * cs - x2 * sn);
        }
        float* d = smp ? p.out + OFF_KR_S + (size_t)(tok - TP) * 32 + c4 : p.out + OFF_KR_P + (size_t)tok * 32 + c4;
        st_nt4(d, make_float4(o[0], o[1], o[2], o[3]));
        st_bf4(p.Kmla() + (size_t)tok * 160 + 128 + c4, o[0], o[1], o[2], o[3]);
      }
    } else if (nt < 8) {
      st_bf4(p.gm() + (size_t)tok * 512 + (nt - 4) * 128 + c4, silu(v.x), silu(v.y), silu(v.z), silu(v.w));
    } else if (nt < 16) {
      const bool isq = nt < 12;
      const int c512 = (nt - (isq ? 8 : 12)) * 128 + c4;
      const int d = c512 & 63;
      float o[4] = {v.x, v.y, v.z, v.w};
      if (d < 16) {
        const bool second = d >= 8; const int i0 = d & 7; const int gb = c4 - d;
#pragma unroll
        for (int e = 0; e < 4; ++e) {
          int i = i0 + e;
          float x1 = cr[gb + i], x2 = cr[gb + 8 + i];
          float cs = p.ropeC()[pos * 24 + 16 + i], sn = p.ropeS()[pos * 24 + 16 + i];
          o[e] = second ? (x1 * sn + x2 * cs) : (x1 * cs - x2 * sn);
        }
      }
      if (isq) {
        st_bf4(p.dqb() + (size_t)tok * 512 + c512, o[0] * QS_64, o[1] * QS_64, o[2] * QS_64, o[3] * QS_64);
      } else {
        float* dd = smp ? p.out + OFF_DK_S + (size_t)(tok - TP) * 512 + c512 : p.out + OFF_DK_P + (size_t)tok * 512 + c512;
        st_nt4(dd, make_float4(o[0], o[1], o[2], o[3]));
        st_bf4(p.dkb() + (size_t)tok * 512 + c512, o[0], o[1], o[2], o[3]);
      }
    } else if (nt < 20) {
      const int c512 = (nt - 16) * 128 + c4;
      float* dd = smp ? p.out + OFF_DV_S + (size_t)(tok - TP) * 512 + c512 : p.out + OFF_DV_P + (size_t)tok * 512 + c512;
      st_nt4(dd, v);
      st_bf4(p.dvb() + (size_t)tok * 512 + c512, v.x, v.y, v.z, v.w);
    } else {
      st_bf4(p.gd() + (size_t)tok * 512 + (nt - 20) * 128 + c4, silu(v.x), silu(v.y), silu(v.z), silu(v.w));
    }
  }
}

DI void epi_e1b(const Params& p, int mt, int nt, const float* Cs) {
  const int tid = otid(), c4 = (tid & 31) * 4;
  for (int pp = 0; pp < 16; ++pp) {
    const int row = pp * 8 + (tid >> 5);
    const int tok = mt * 128 + row;
    const bool smp = tok >= TP;
    const int pos = smp ? 2048 + ((tok - TP) & 15) : (tok & 4095);
    const float* cr = Cs + row * CS_LD;
    const float rstd = rsqrtf((p.ssq()[tok * 2] + p.ssq()[tok * 2 + 1]) * (1.f / 256.f) + EPS);
    float4 v = *(const float4*)(cr + c4);
    const int oc = nt * 128 + c4;
    const int c = oc % 160;
    float o[4] = {v.x * rstd, v.y * rstd, v.z * rstd, v.w * rstd};
    if (c >= 128) {
      const int cc = c - 128; const bool second = cc >= 16; const int i0 = cc & 15; const int gb = c4 - cc;
#pragma unroll
      for (int e = 0; e < 4; ++e) {
        int i = i0 + e;
        float x1 = cr[gb + i] * rstd, x2 = cr[gb + 16 + i] * rstd;
        float cs = p.ropeC()[pos * 24 + i], sn = p.ropeS()[pos * 24 + i];
        o[e] = second ? (x1 * sn + x2 * cs) : (x1 * cs - x2 * sn);
      }
    }
    st_bf4(p.Qmla() + (size_t)tok * 1280 + oc, o[0], o[1], o[2], o[3]);
  }
}

DI void epi_out(const Params& p, int mt, int nt, const float* Cs, int layer, int row0 = 0, int npass = 16) {
  const int tid = otid(), c4 = (tid & 31) * 4;
  for (int pp = 0; pp < npass; ++pp) {
    const int row = pp * 8 + (tid >> 5);
    const int tok = mt * 128 + row0 + row;
    const int col = nt * 128 + c4;
    float4 v = *(const float4*)(Cs + row * CS_LD + c4);
    float4 x;
    if (layer == 0) { const f32x4 t = __builtin_nontemporal_load((const f32x4*)(tok < TP ? p.x_prompt + (size_t)tok * 1024 + col : p.x_sample + (size_t)(tok - TP) * 1024 + col)); x = make_float4(t[0], t[1], t[2], t[3]); }
    else { const uint2 yb = *(const uint2*)(p.y0b() + (size_t)tok * 1024 + col); x = make_float4(bflo(yb.x), bfhi(yb.x), bflo(yb.y), bfhi(yb.y)); }
    st_bf4((u16*)p.pre() + (size_t)tok * 1024 + col, ALPHA * x.x + v.x, ALPHA * x.y + v.y, ALPHA * x.z + v.z, ALPHA * x.w + v.w);
  }
}

DI void epi_o1(const Params& p, int mt, int nt, const float* Cs, int row0 = 0, int npass = 16) {
  const int tid = otid(), c4 = (tid & 31) * 4;
  for (int pp = 0; pp < npass; ++pp) {
    const int row = pp * 8 + (tid >> 5);
    const int tok = mt * 128 + row0 + row;
    const bool smp = tok >= TP;
    float4 v = *(const float4*)(Cs + row * CS_LD + c4);
    const int sec = nt >> 3; const int col = (nt & 7) * 128 + c4;
    if (sec == 0) st_bf4(p.sqb() + (size_t)tok * 1024 + col, v.x * QS_64, v.y * QS_64, v.z * QS_64, v.w * QS_64);
    else if (sec == 1) {
      float* d = smp ? p.out + OFF_SK_S + (size_t)(tok - TP) * 1024 + col : p.out + OFF_SK_P + (size_t)tok * 1024 + col;
      st_nt4(d, v); st_bf4(p.skb() + (size_t)tok * 1024 + col, v.x, v.y, v.z, v.w);
    } else if (sec == 2) {
      float* d = smp ? p.out + OFF_SV_S + (size_t)(tok - TP) * 1024 + col : p.out + OFF_SV_P + (size_t)tok * 1024 + col;
      st_nt4(d, v); st_bf4(p.svb() + (size_t)tok * 1024 + col, v.x, v.y, v.z, v.w);
    } else st_bf4(p.sgb() + (size_t)tok * 1024 + col, silu(v.x), silu(v.y), silu(v.z), silu(v.w));
  }
}

DI void phase_ln(const Params& p, int layer) {
  const int tid = otid(); const int lane = tid & 63, w = tid >> 6;
  const float* g = layer == 0 ? p.ln_e_g : p.ln_o_g;
  const float* bb = layer == 0 ? p.ln_e_b : p.ln_o_b;
  for (int row = blockIdx.x * 4 + w; row < T; row += gridDim.x * 4) {
    const u16* s = (const u16*)p.pre() + (size_t)row * 1024;
    float4 v[4];
    float sum = 0.f;
#pragma unroll
    for (int i = 0; i < 4; ++i) {
      typedef __attribute__((ext_vector_type(2))) unsigned u32x2_t;
      const u32x2_t qq = __builtin_nontemporal_load((const u32x2_t*)(s + lane * 4 + 256 * i));
      const uint2 q = make_uint2(qq[0], qq[1]);
      v[i] = make_float4(bflo(q.x), bfhi(q.x), bflo(q.y), bfhi(q.y));
      sum += v[i].x + v[i].y + v[i].z + v[i].w;
    }
    const float mu = wave_sum(sum) * (1.f / 1024.f);
    float sq = 0.f;
#pragma unroll
    for (int i = 0; i < 4; ++i) { v[i].x -= mu; v[i].y -= mu; v[i].z -= mu; v[i].w -= mu; sq += v[i].x * v[i].x + v[i].y * v[i].y + v[i].z * v[i].z + v[i].w * v[i].w; }
    const float rstd = rsqrtf(wave_sum(sq) * (1.f / 1024.f) + EPS);
#pragma unroll
    for (int i = 0; i < 4; ++i) {
      const int c = lane * 4 + 256 * i;
      float4 gg = *(const float4*)(g + c), b4 = *(const float4*)(bb + c);
      float4 y = make_float4(v[i].x * rstd * gg.x + b4.x, v[i].y * rstd * gg.y + b4.y, v[i].z * rstd * gg.z + b4.z, v[i].w * rstd * gg.w + b4.w);
      if (layer == 0) {
        st_bf4(p.y0b() + (size_t)row * 1024 + c, y.x, y.y, y.z, y.w);
      } else {
        float* d = row < TP ? p.out + OFF_YP + (size_t)row * 1024 + c : p.out + OFF_YS + (size_t)(row - TP) * 1024 + c;
        st_nt4(d, y);
      }
    }
  }
}

template <int W>
DI void load_bf16(int tid, char* dst, int rs, int coff, const u16* __restrict__ src, size_t ld, int nvalid) {
  constexpr int CPR = W / 8; constexpr int TOT = 64 * CPR;
#pragma unroll
  for (int c0 = 0; c0 < TOT; c0 += 256) {
    int c = c0 + tid;
    if (c < TOT) {
      int row = c / CPR, cc = c % CPR;
      uint4 v = make_uint4(0, 0, 0, 0);
      if (row < nvalid) v = *(const uint4*)(src + (size_t)row * ld + cc * 8);
      *(uint4*)(dst + row * rs + coff + cc * 16) = v;
    }
  }
}
template <int W>
DI void load_f32(int tid, char* dst, int rs, int coff, const float* __restrict__ src, size_t ld, int nvalid) {
  constexpr int CPR = W / 8; constexpr int TOT = 64 * CPR;
#pragma unroll
  for (int c0 = 0; c0 < TOT; c0 += 256) {
    int c = c0 + tid;
    if (c < TOT) {
      int row = c / CPR, cc = c % CPR;
      uint4 v = make_uint4(0, 0, 0, 0);
      if (row < nvalid) {
        const float* s = src + (size_t)row * ld + cc * 8;
        float4 a = *(const float4*)s, b = *(const float4*)(s + 4);
        v.x = pk2(a.x, a.y); v.y = pk2(a.z, a.w); v.z = pk2(b.x, b.y); v.w = pk2(b.z, b.w);
      }
      *(uint4*)(dst + row * rs + coff + cc * 16) = v;
    }
  }
}

template <int NK>
DI void qk_half(const char* kb, int rs, const bf16x8 (&qf)[NK], f32x16& s, int r, int h) {
  const int pr = (r & 19) | ((r & 4) << 1) | ((r & 8) >> 1);
#pragma unroll
  for (int e = 0; e < 16; ++e) s[e] = 0.f;
  bf16x8 kf[NK];
#pragma unroll
  for (int kk = 0; kk < NK; ++kk) kf[kk] = *(const bf16x8*)(kb + pr * rs + kk * 32 + h * 16);
  __builtin_amdgcn_sched_barrier(0);
  __builtin_amdgcn_s_setprio(1);
#pragma unroll
  for (int kk = 0; kk < NK; ++kk) s = MFMA(kf[kk], qf[kk], s);
  __builtin_amdgcn_s_setprio(0);
}
template <int NDT>
DI void pv_half(const char* vb, int rs, const bf16x8 (&pf)[2], f32x16 (&o)[NDT], int lane) {
  const int i16 = lane & 15, q4 = i16 >> 2, p4 = i16 & 3, blk = (lane >> 4) & 1, h = lane >> 5;
  const char* base = vb + (8 * h + q4) * rs + (16 * blk + 4 * p4) * 2;
  s16x4 lo[NDT][2], hi[NDT][2];
#pragma unroll
  for (int dt = 0; dt < NDT; ++dt)
#pragma unroll
    for (int s2 = 0; s2 < 2; ++s2) {
      const char* ad = base + (16 * s2) * rs + dt * 64;
      lo[dt][s2] = __builtin_amdgcn_ds_read_tr16_b64_v4i16((LAS s16x4*)(ad));
      hi[dt][s2] = __builtin_amdgcn_ds_read_tr16_b64_v4i16((LAS s16x4*)(ad + 4 * rs));
    }
  __builtin_amdgcn_sched_barrier(0);
  __builtin_amdgcn_s_setprio(1);
#pragma unroll
  for (int s2 = 0; s2 < 2; ++s2)
#pragma unroll
    for (int dt = 0; dt < NDT; ++dt) {
      bf16x8 a = __builtin_shufflevector(lo[dt][s2], hi[dt][s2], 0, 1, 2, 3, 4, 5, 6, 7);
      o[dt] = MFMA(a, pf[s2], o[dt]);
    }
  __builtin_amdgcn_s_setprio(0);
}
template <int NDT>
DI void softmax_half(f32x16& s, float& m, float& l, f32x16 (&o)[NDT], bf16x8 (&pf)[2], int nvalid, int h) {
  if (nvalid < 32) {
#pragma unroll
    for (int i = 0; i < 16; ++i) {
      int key = (i & 7) + 8 * h + 16 * (i >> 3);
      if (key >= nvalid) s[i] = -1e30f;
    }
  }
  float mx = -1e30f;
#pragma unroll
  for (int i = 0; i < 16; ++i) mx = fmaxf(mx, s[i]);
  mx = x32_max(mx);
  if (!__all(mx - m <= 6.f)) {
    const float mnew = fmaxf(m, mx);
    const float alpha = ex2(m - mnew);
    m = mnew;
    l *= alpha;
#pragma unroll
    for (int dt = 0; dt < NDT; ++dt)
#pragma unroll
      for (int i = 0; i < 16; ++i) o[dt][i] *= alpha;
  }
  const float mn = m;
  float ls = 0.f;
#pragma unroll
  for (int i = 0; i < 16; ++i) { float pv = ex2(s[i] - mn); s[i] = pv; ls += pv; }
#pragma unroll
  for (int s2 = 0; s2 < 2; ++s2)
    pf[s2] = pack8(s[8 * s2], s[8 * s2 + 1], s[8 * s2 + 2], s[8 * s2 + 3], s[8 * s2 + 4], s[8 * s2 + 5], s[8 * s2 + 6], s[8 * s2 + 7]);
  l += ls;
}
#define SGB_MFMA_VALU(nv) do { __builtin_amdgcn_sched_group_barrier(0x008, 1, 0); __builtin_amdgcn_sched_group_barrier(0x002, (nv), 0); } while (0)
template <int NDT>
DI void sm_finish(f32x16& s, f32x16& pe, float mx, float& m, float& l, f32x16 (&o)[NDT], bf16x8 (&pf)[2]) {
  if (!__all(mx - m <= 6.f)) {
    const float mnew = fmaxf(m, mx);
    const float alpha = ex2(m - mnew);
    m = mnew;
    l *= alpha;
#pragma unroll
    for (int dt = 0; dt < NDT; ++dt)
#pragma unroll
      for (int i = 0; i < 16; ++i) o[dt][i] *= alpha;
#pragma unroll
    for (int i = 0; i < 16; ++i) pe[i] = ex2(s[i] - mnew);
  }
  float ls = 0.f;
#pragma unroll
  for (int i = 0; i < 16; ++i) ls += pe[i];
  l += ls;
#pragma unroll
  for (int s2 = 0; s2 < 2; ++s2)
    pf[s2] = pack8(pe[8 * s2], pe[8 * s2 + 1], pe[8 * s2 + 2], pe[8 * s2 + 3], pe[8 * s2 + 4], pe[8 * s2 + 5], pe[8 * s2 + 6], pe[8 * s2 + 7]);
}
template <int NK, int NDT>
DI void attn_tile64(const char* kb, int rsk, const char* vb, int rsv, const bf16x8 (&qf)[NK], float& m, float& l, f32x16 (&o)[NDT], int lane) {
  const int r = lane & 31, h = lane >> 5;
  const int pr = (r & 19) | ((r & 4) << 1) | ((r & 8) >> 1);
  const int i16 = lane & 15, q4 = i16 >> 2, p4 = i16 & 3, blk = (lane >> 4) & 1;
  const char* krow = kb + pr * rsk + h * 16;
  const char* vbase = vb + (8 * h + q4) * rsv + (16 * blk + 4 * p4) * 2;
  f32x16 s0, s1;
#pragma unroll
  for (int e = 0; e < 16; ++e) { s0[e] = 0.f; s1[e] = 0.f; }
  {
    bf16x8 kf[NK];
#pragma unroll
    for (int kk = 0; kk < NK; ++kk) kf[kk] = *(const bf16x8*)(krow + kk * 32);
    __builtin_amdgcn_sched_barrier(0);
#pragma unroll
    for (int kk = 0; kk < NK; ++kk) s0 = MFMA(kf[kk], qf[kk], s0);
  }
  bf16x8 kf1[NK];
#pragma unroll
  for (int kk = 0; kk < NK; ++kk) kf1[kk] = *(const bf16x8*)(krow + 32 * rsk + kk * 32);
  __builtin_amdgcn_sched_barrier(0);
#pragma unroll
  for (int kk = 0; kk < NK; ++kk) s1 = MFMA(kf1[kk], qf[kk], s1);
  float mx0 = -1e30f;
#pragma unroll
  for (int i = 0; i < 16; ++i) mx0 = fmaxf(mx0, s0[i]);
  mx0 = x32_max(mx0);
  f32x16 pe0;
#pragma unroll
  for (int i = 0; i < 16; ++i) { pe0[i] = ex2(s0[i] - m); asm volatile("" : "+v"(pe0[i])); }
#pragma unroll
  for (int kk = 0; kk < NK; ++kk) SGB_MFMA_VALU((48 + NK - 1) / NK);
  __builtin_amdgcn_sched_barrier(0);
  bf16x8 pf0[2];
  sm_finish<NDT>(s0, pe0, mx0, m, l, o, pf0);
  s16x4 lo[NDT][2], hi[NDT][2];
#pragma unroll
  for (int dt = 0; dt < NDT; ++dt)
#pragma unroll
    for (int s2 = 0; s2 < 2; ++s2) {
      const char* ad = vbase + (16 * s2) * rsv + dt * 64;
      lo[dt][s2] = __builtin_amdgcn_ds_read_tr16_b64_v4i16((LAS s16x4*)(ad));
      hi[dt][s2] = __builtin_amdgcn_ds_read_tr16_b64_v4i16((LAS s16x4*)(ad + 4 * rsv));
    }
  __builtin_amdgcn_sched_barrier(0);
#pragma unroll
  for (int s2 = 0; s2 < 2; ++s2)
#pragma unroll
    for (int dt = 0; dt < NDT; ++dt) {
      bf16x8 a = __builtin_shufflevector(lo[dt][s2], hi[dt][s2], 0, 1, 2, 3, 4, 5, 6, 7);
      o[dt] = MFMA(a, pf0[s2], o[dt]);
    }
  float mx1 = -1e30f;
#pragma unroll
  for (int i = 0; i < 16; ++i) mx1 = fmaxf(mx1, s1[i]);
  mx1 = x32_max(mx1);
  f32x16 pe1;
#pragma unroll
  for (int i = 0; i < 16; ++i) { pe1[i] = ex2(s1[i] - m); asm volatile("" : "+v"(pe1[i])); }
#pragma unroll
  for (int k = 0; k < 2 * NDT; ++k) SGB_MFMA_VALU((48 + 2 * NDT - 1) / (2 * NDT));
  __builtin_amdgcn_sched_barrier(0);
  bf16x8 pf1[2];
  sm_finish<NDT>(s1, pe1, mx1, m, l, o, pf1);
  pv_half<NDT>(vb + 32 * rsv, rsv, pf1, o, lane);
}

template <bool MASKED>
DI void sb_half(f32x16& s, float& carry, bf16x8 (&pf)[2], int limit, int h) {
  f32x16 rem;
#pragma unroll
  for (int i = 0; i < 16; ++i) {
    const float z = fmaxf(s[i], -100.f);
    const float t = ex2(-z);
    const float beta = __builtin_amdgcn_rcpf(1.f + t);
    const float omb = t * beta;
    if (MASKED) {
      const int key = (i & 7) + 8 * h + 16 * (i >> 3);
      const bool valid = key < limit;
      s[i] = valid ? beta : 0.f;
      rem[i] = valid ? omb : 1.f;
    } else { s[i] = beta; rem[i] = omb; }
  }
  float Tt[2], To[2];
#pragma unroll
  for (int u = 0; u < 2; ++u) {
    float run = 1.f;
#pragma unroll
    for (int j = 7; j >= 0; --j) { float tmp = rem[8 * u + j]; rem[8 * u + j] = run; run *= tmp; }
    Tt[u] = run;
  }
#pragma unroll
  for (int u = 0; u < 2; ++u) To[u] = x32_other(Tt[u], h);
  float acc = carry;
#pragma unroll
  for (int u = 1; u >= 0; --u) {
    const float off = acc * (h == 0 ? To[u] : 1.f);
#pragma unroll
    for (int j = 0; j < 8; ++j) s[8 * u + j] = s[8 * u + j] * rem[8 * u + j] * off;
    acc *= Tt[u] * To[u];
  }
  carry = acc;
#pragma unroll
  for (int s2 = 0; s2 < 2; ++s2)
    pf[s2] = pack8(s[8 * s2], s[8 * s2 + 1], s[8 * s2 + 2], s[8 * s2 + 3], s[8 * s2 + 4], s[8 * s2 + 5], s[8 * s2 + 6], s[8 * s2 + 7]);
}

DI u32x4 ldg16(const void* p) { return *(const u32x4*)p; }
DI u32x4 ldg16_nt(const void* p) { return __builtin_nontemporal_load((const u32x4*)p); }
DI u32x4 cvt8(u32x4 a, u32x4 b) {
  u32x4 o;
  o[0] = pk2(__uint_as_float(a[0]), __uint_as_float(a[1])); o[1] = pk2(__uint_as_float(a[2]), __uint_as_float(a[3]));
  o[2] = pk2(__uint_as_float(b[0]), __uint_as_float(b[1])); o[3] = pk2(__uint_as_float(b[2]), __uint_as_float(b[3]));
  return o;
}
struct Stage128 { u32x4 v[8]; };
DI void issue128_full(Stage128& st, int tid, const u16* ksrc, const u16* vsrc, size_t ld) {
#pragma unroll
  for (int i = 0; i < 4; ++i) {
    const int c = tid + 256 * i, row = c >> 4, cc = c & 15;
    st.v[i] = ldg16(ksrc + (size_t)row * ld + cc * 8);
    st.v[4 + i] = ldg16(vsrc + (size_t)row * ld + cc * 8);
  }
}
DI void commit128_full(const Stage128& st, int tid, char* Kt, int rsk, char* Vt, int rsv) {
#pragma unroll
  for (int i = 0; i < 4; ++i) {
    const int c = tid + 256 * i, row = c >> 4, cc = c & 15;
    *(u32x4*)(Kt + row * rsk + cc * 16) = st.v[i];
    *(u32x4*)(Vt + row * rsv + cc * 16) = st.v[4 + i];
  }
}
DI void issue128_bf16(Stage128& st, int tid, const u16* ksrc, const u16* vsrc, size_t ld, int nrows, int nvalid) {
#pragma unroll
  for (int i = 0; i < 4; ++i) {
    const int c = tid + 256 * i, row = c >> 4, cc = c & 15;
    u32x4 z = {0u, 0u, 0u, 0u};
    const bool ok = (row < nvalid) && (row < nrows);
    st.v[i] = ok ? ldg16(ksrc + (size_t)row * ld + cc * 8) : z;
    st.v[4 + i] = ok ? ldg16(vsrc + (size_t)row * ld + cc * 8) : z;
  }
}
DI void commit128_bf16(const Stage128& st, int tid, char* Kt, int rsk, char* Vt, int rsv, int nrows) {
#pragma unroll
  for (int i = 0; i < 4; ++i) {
    const int c = tid + 256 * i, row = c >> 4, cc = c & 15;
    if (row < nrows) {
      *(u32x4*)(Kt + row * rsk + cc * 16) = st.v[i];
      *(u32x4*)(Vt + row * rsv + cc * 16) = st.v[4 + i];
    }
  }
}
DI void issue128_f32(Stage128& st, int tid, const float* ksrc, const float* vsrc, size_t ld) {
#pragma unroll
  for (int i = 0; i < 2; ++i) {
    const int c = tid + 256 * i, row = c >> 4, cc = c & 15;
    const float* kp = ksrc + (size_t)row * ld + cc * 8;
    const float* vp = vsrc + (size_t)row * ld + cc * 8;
    st.v[2 * i] = ldg16_nt(kp); st.v[2 * i + 1] = ldg16_nt(kp + 4);
    st.v[4 + 2 * i] = ldg16_nt(vp); st.v[4 + 2 * i + 1] = ldg16_nt(vp + 4);
  }
}
DI void commit128_f32(const Stage128& st, int tid, char* Kt, int rsk, char* Vt, int rsv) {
#pragma unroll
  for (int i = 0; i < 2; ++i) {
    const int c = tid + 256 * i, row = c >> 4, cc = c & 15;
    *(u32x4*)(Kt + row * rsk + cc * 16) = cvt8(st.v[2 * i], st.v[2 * i + 1]);
    *(u32x4*)(Vt + row * rsv + cc * 16) = cvt8(st.v[4 + 2 * i], st.v[4 + 2 * i + 1]);
  }
}
struct Stage160 { u32x4 v[6]; };
DI void issue160_full(Stage160& st, int tid, const u16* src) {
#pragma unroll
  for (int i = 0; i < 5; ++i) {
    const int c = tid + 256 * i, row = c / 20, cc = c % 20;
    st.v[i] = ldg16(src + (size_t)row * 160 + cc * 8);
  }
}
DI void commit160_full(const Stage160& st, int tid, char* Kt, int rs) {
#pragma unroll
  for (int i = 0; i < 5; ++i) {
    const int c = tid + 256 * i, row = c / 20, cc = c % 20;
    *(u32x4*)(Kt + row * rs + cc * 16) = st.v[i];
  }
}
DI void issue160_bf16(Stage160& st, int tid, const u16* src, int nrows, int nvalid) {
#pragma unroll
  for (int i = 0; i < 5; ++i) {
    const int c = tid + 256 * i, row = c / 20, cc = c % 20;
    u32x4 z = {0u, 0u, 0u, 0u};
    st.v[i] = (row < nvalid && row < nrows) ? ldg16(src + (size_t)row * 160 + cc * 8) : z;
  }
}
DI void commit160_bf16(const Stage160& st, int tid, char* Kt, int rs, int nrows) {
#pragma unroll
  for (int i = 0; i < 5; ++i) {
    const int c = tid + 256 * i, row = c / 20, cc = c % 20;
    if (row < nrows) *(u32x4*)(Kt + row * rs + cc * 16) = st.v[i];
  }
}
DI void issue160_f32(Stage160& st, int tid, const float* ckv, const float* kr) {
#pragma unroll
  for (int i = 0; i < 2; ++i) {
    const int c = tid + 256 * i, row = c >> 4, cc = c & 15;
    const float* kp = ckv + (size_t)row * 128 + cc * 8;
    st.v[2 * i] = ldg16_nt(kp); st.v[2 * i + 1] = ldg16_nt(kp + 4);
  }
  {
    const int c = tid & 127, row = c >> 2, cc = c & 3;
    const float* kp = kr + (size_t)row * 32 + cc * 8;
    st.v[4] = ldg16_nt(kp); st.v[5] = ldg16_nt(kp + 4);
  }
}
DI void commit160_f32(const Stage160& st, int tid, char* Kt, int rs) {
#pragma unroll
  for (int i = 0; i < 2; ++i) {
    const int c = tid + 256 * i, row = c >> 4, cc = c & 15;
    *(u32x4*)(Kt + row * rs + cc * 16) = cvt8(st.v[2 * i], st.v[2 * i + 1]);
  }
  {
    const int c = tid & 127, row = c >> 2, cc = c & 3;
    *(u32x4*)(Kt + row * rs + 256 + cc * 16) = cvt8(st.v[4], st.v[5]);
  }
}

template <bool SMP>
DI void run_mla(const Params& p, int b, int qb, int hp, char* smem) {
  const int tid = otid(), lane = tid & 63, w = tid >> 6, r = lane & 31, h = lane >> 5;
  int head, tok;
  if (!SMP) { head = 2 * hp + (w >> 1); tok = b * 4096 + qb * 64 + (w & 1) * 32 + r; }
  else { head = 2 * w + (r >> 4); tok = TP + b * 16 + (r & 15); }
  const u16* qptr = p.Qmla() + (size_t)tok * 1280 + head * 160;
  f32x16 o[4];
#pragma unroll
  for (int dt = 0; dt < 4; ++dt)
#pragma unroll
    for (int i = 0; i < 16; ++i) o[dt][i] = 0.f;
  float m = -1e30f, l = 0.f;
  constexpr int RS = 336;
  const int niter = SMP ? 65 : qb + 1;
  Stage160 st;
  constexpr int TILEB = 64 * RS;
  auto issue = [&](int t) {
    if (!SMP) issue160_full(st, tid, p.Kmla() + (size_t)(b * 4096 + t * 64) * 160);
    else if (t < 64) issue160_f32(st, tid, p.c_ckv + (size_t)(b * 2048 + t * 32) * 128, p.c_krope + (size_t)(b * 2048 + t * 32) * 32);
    else issue160_bf16(st, tid, p.Kmla() + (size_t)(TP + b * 16) * 160, 32, 16);
  };
  auto commit = [&](int t, char* dst) {
    if (!SMP) commit160_full(st, tid, dst, RS);
    else if (t < 64) commit160_f32(st, tid, dst, RS);
    else commit160_bf16(st, tid, dst, RS, 32);
  };
  issue(0);
  bf16x8 qf[10];
#pragma unroll
  for (int kk = 0; kk < 10; ++kk) qf[kk] = *(const bf16x8*)(qptr + kk * 16 + h * 8);
  commit(0, smem);
#pragma unroll
  for (int kk = 0; kk < 10; ++kk) asm volatile("" : "+v"(qf[kk]));
  if (niter > 1) issue(1);
  __syncthreads();
  for (int it = 0; it < niter; ++it) {
    const char* cur = smem + (it & 1) * TILEB;
    const int nhalf = SMP ? 1 : 2;
    const int nvalid = (SMP && it == 64) ? 16 : 32;
    if (nhalf == 2) {
      attn_tile64<10, 4>(cur, RS, cur, RS, qf, m, l, o, lane);
    } else {
      f32x16 s;
      qk_half<10>(cur, RS, qf, s, r, h);
      bf16x8 pf[2];
      softmax_half<4>(s, m, l, o, pf, nvalid, h);
      pv_half<4>(cur, RS, pf, o, lane);
    }
    if (it + 1 < niter) {
      commit(it + 1, smem + ((it + 1) & 1) * TILEB);
      if (it + 2 < niter) issue(it + 2);
    }
    __syncthreads();
  }
  const float inv = 1.f / x32_sum(l);
  const int npass = SMP ? 2 : 1;
  for (int pass = 0; pass < npass; ++pass) {
    const int hd = SMP ? 2 * w + pass : head;
    f32x16 res[2];
#pragma unroll
    for (int vt = 0; vt < 2; ++vt)
#pragma unroll
      for (int i = 0; i < 16; ++i) res[vt][i] = 0.f;
#pragma unroll
    for (int ct = 0; ct < 4; ++ct)
#pragma unroll
      for (int s2 = 0; s2 < 2; ++s2) {
        bf16x8 bfr = pack8(o[ct][8 * s2] * inv, o[ct][8 * s2 + 1] * inv, o[ct][8 * s2 + 2] * inv, o[ct][8 * s2 + 3] * inv,
                           o[ct][8 * s2 + 4] * inv, o[ct][8 * s2 + 5] * inv, o[ct][8 * s2 + 6] * inv, o[ct][8 * s2 + 7] * inv);
#pragma unroll
        for (int vt = 0; vt < 2; ++vt) {
          const u16* wp = p.Wt_uv() + (size_t)(hd * 64 + vt * 32 + r) * 128 + ct * 32 + 16 * s2 + 4 * h;
          s16x4 lo = *(const s16x4*)wp, hi = *(const s16x4*)(wp + 8);
          bf16x8 a = __builtin_shufflevector(lo, hi, 0, 1, 2, 3, 4, 5, 6, 7);
          res[vt] = MFMA(a, bfr, res[vt]);
        }
      }
    if (!SMP || (r >> 4) == pass) {
#pragma unroll
      for (int vt = 0; vt < 2; ++vt)
#pragma unroll
        for (int i4 = 0; i4 < 4; ++i4) {
          const int v0 = vt * 32 + 8 * i4 + 4 * h;
          uint2 g = *(const uint2*)(p.gm() + (size_t)tok * 512 + hd * 64 + v0);
          st_bf4(p.A2() + (size_t)tok * 1024 + hd * 64 + v0, res[vt][4 * i4] * bflo(g.x), res[vt][4 * i4 + 1] * bfhi(g.x),
                 res[vt][4 * i4 + 2] * bflo(g.y), res[vt][4 * i4 + 3] * bfhi(g.y));
        }
    }
  }
}

template <bool SMP>
DI void run_diff(const Params& p, int b, int qb, int hd, char* smem) {
  const int tid = otid(), lane = tid & 63, w = tid >> 6, r = lane & 31, h = lane >> 5;
  const int slot = w >> 1, qh = w & 1;
  const bool active = SMP ? (qh == 0) : true;
  const bool rowvalid = SMP ? (r < 16) : true;
  const int tok = SMP ? TP + b * 16 + (r & 15) : b * 4096 + qb * 64 + qh * 32 + r;
  const u16* qptr = p.dqb() + (size_t)tok * 512 + hd * 128 + slot * 64;
  f32x16 o[4];
#pragma unroll
  for (int dt = 0; dt < 4; ++dt)
#pragma unroll
    for (int i = 0; i < 16; ++i) o[dt][i] = 0.f;
  float m = -1e30f, l = 0.f;
  constexpr int RSK = 272, RSV = 320;
  const int niter = SMP ? 65 : qb + 1;
  Stage128 st;
  constexpr int TILEB = 64 * RSK + 64 * RSV;
  auto issue = [&](int t) {
    if (!SMP) { const size_t ro = (size_t)(b * 4096 + t * 64) * 512 + hd * 128; issue128_full(st, tid, p.dkb() + ro, p.dvb() + ro, 512); }
    else if (t < 64) { const size_t ro = (size_t)(b * 2048 + t * 32) * 512 + hd * 128; issue128_f32(st, tid, p.c_dk + ro, p.c_dv + ro, 512); }
    else { const size_t ro = (size_t)(TP + b * 16) * 512 + hd * 128; issue128_bf16(st, tid, p.dkb() + ro, p.dvb() + ro, 512, 32, 16); }
  };
  auto commit = [&](int t, char* dst) {
    if (!SMP) commit128_full(st, tid, dst, RSK, dst + 64 * RSK, RSV);
    else if (t < 64) commit128_f32(st, tid, dst, RSK, dst + 64 * RSK, RSV);
    else commit128_bf16(st, tid, dst, RSK, dst + 64 * RSK, RSV, 32);
  };
  issue(0);
  bf16x8 qf[4];
#pragma unroll
  for (int kk = 0; kk < 4; ++kk) {
    bf16x8 z = {0, 0, 0, 0, 0, 0, 0, 0};
    qf[kk] = rowvalid ? *(const bf16x8*)(qptr + kk * 16 + h * 8) : z;
  }
  commit(0, smem);
#pragma unroll
  for (int kk = 0; kk < 4; ++kk) asm volatile("" : "+v"(qf[kk]));
  if (niter > 1) issue(1);
  __syncthreads();
  for (int it = 0; it < niter; ++it) {
    const char* Kc = smem + (it & 1) * TILEB; const char* Vc = Kc + 64 * RSK;
    if (active) {
      const int nhalf = SMP ? 1 : 2;
      const int nvalid = (SMP && it == 64) ? 16 : 32;
      if (nhalf == 2) {
        attn_tile64<4, 4>(Kc + slot * 128, RSK, Vc, RSV, qf, m, l, o, lane);
      } else {
        f32x16 s;
        qk_half<4>(Kc + slot * 128, RSK, qf, s, r, h);
        bf16x8 pf[2];
        softmax_half<4>(s, m, l, o, pf, nvalid, h);
        pv_half<4>(Vc, RSV, pf, o, lane);
      }
    }
    if (it + 1 < niter) {
      commit(it + 1, smem + ((it + 1) & 1) * TILEB);
      if (it + 2 < niter) issue(it + 2);
    }
    __syncthreads();
  }
  const float inv = 1.f / x32_sum(l);
  __syncthreads();
  float* buf = (float*)smem;
  const int ql = qh * 32 + r;
  if (slot == 1 && active) {
#pragma unroll
    for (int dt = 0; dt < 4; ++dt)
#pragma unroll
      for (int i = 0; i < 16; ++i) buf[ql * 132 + 32 * dt + crow(i, h)] = o[dt][i] * inv;
  }
  __syncthreads();
  if (slot == 0 && active) {
    const float lam = p.lam()[0];
    float ss = 0.f;
#pragma unroll
    for (int dt = 0; dt < 4; ++dt)
#pragma unroll
      for (int i = 0; i < 16; ++i) {
        float x = o[dt][i] * inv - lam * buf[ql * 132 + 32 * dt + crow(i, h)];
        o[dt][i] = x; ss += x * x;
      }
    ss = x32_sum(ss);
    const float rstd = rsqrtf(ss * (1.f / 128.f) + EPS) * (1.f - LAM_INIT);
    if (rowvalid) {
#pragma unroll
      for (int dt = 0; dt < 4; ++dt)
#pragma unroll
        for (int i4 = 0; i4 < 4; ++i4) {
          const int d0 = 32 * dt + 8 * i4 + 4 * h;
          uint2 g = *(const uint2*)(p.gd() + (size_t)tok * 512 + hd * 128 + d0);
          float4 sg = *(const float4*)(p.subln_g + d0);
          st_bf4(p.A2() + (size_t)tok * 1024 + 512 + hd * 128 + d0, o[dt][4 * i4] * rstd * sg.x * bflo(g.x), o[dt][4 * i4 + 1] * rstd * sg.y * bfhi(g.x),
                 o[dt][4 * i4 + 2] * rstd * sg.z * bflo(g.y), o[dt][4 * i4 + 3] * rstd * sg.w * bfhi(g.y));
        }
    }
  }
}

template <bool SMP>
DI void run_sb(const Params& p, int b, int qb, int hp, char* smem) {
  const int tid = otid(), lane = tid & 63, w = tid >> 6, r = lane & 31, h = lane >> 5;
  const int slot = w >> 1, qh = w & 1;
  const int head = 2 * hp + slot;
  const bool active = SMP ? (qh == 0) : true;
  const bool rowvalid = SMP ? (r < 16) : true;
  const int tok = SMP ? TP + b * 16 + (r & 15) : b * 4096 + qb * 64 + qh * 32 + r;
  const u16* qptr = p.sqb() + (size_t)tok * 1024 + head * 64;
  f32x16 o[2];
#pragma unroll
  for (int dt = 0; dt < 2; ++dt)
#pragma unroll
    for (int i = 0; i < 16; ++i) o[dt][i] = 0.f;
  float carry = 1.f;
  bool wdone = !active;
  constexpr int RSK = 272, RSV = 320;
  volatile int* flags = (volatile int*)(smem + SMEM_MAIN);
  const int niter = SMP ? 65 : qb + 1;
  Stage128 st;
  constexpr int TILEB = 64 * RSK + 64 * RSV;
  auto issue = [&](int t) {
    if (!SMP) { const size_t ro = (size_t)(b * 4096 + (qb - t) * 64) * 1024 + hp * 128; issue128_full(st, tid, p.skb() + ro, p.svb() + ro, 1024); }
    else if (t == 0) { const size_t ro = (size_t)(TP + b * 16) * 1024 + hp * 128; issue128_bf16(st, tid, p.skb() + ro, p.svb() + ro, 1024, 32, 16); }
    else { const size_t ro = (size_t)(b * 2048 + (64 - t) * 32) * 1024 + hp * 128; issue128_f32(st, tid, p.c_sk + ro, p.c_sv + ro, 1024); }
  };
  auto commit = [&](int t, char* dst) {
    if (!SMP) commit128_full(st, tid, dst, RSK, dst + 64 * RSK, RSV);
    else if (t == 0) commit128_bf16(st, tid, dst, RSK, dst + 64 * RSK, RSV, 32);
    else commit128_f32(st, tid, dst, RSK, dst + 64 * RSK, RSV);
  };
  issue(0);
  bf16x8 qf[4];
#pragma unroll
  for (int kk = 0; kk < 4; ++kk) {
    bf16x8 z = {0, 0, 0, 0, 0, 0, 0, 0};
    qf[kk] = rowvalid ? *(const bf16x8*)(qptr + kk * 16 + h * 8) : z;
  }
  commit(0, smem);
#pragma unroll
  for (int kk = 0; kk < 4; ++kk) asm volatile("" : "+v"(qf[kk]));
  if (niter > 1) issue(1);
  __syncthreads();
  for (int it = 0; it < niter; ++it) {
    const char* Kc = smem + (it & 1) * TILEB; const char* Vc = Kc + 64 * RSK;
    if (!wdone) {
      int limit, wlimit;
      if (SMP) { if (it == 0) { limit = r & 15; wlimit = 16; } else { limit = 32; wlimit = 32; } }
      else if (it == 0) { limit = qh * 32 + r; wlimit = qh * 32 + 32; }
      else { limit = 64; wlimit = 64; }
      for (int kt2 = (wlimit > 32 ? 1 : 0); kt2 >= 0; --kt2) {
        f32x16 s;
        qk_half<4>(Kc + slot * 128 + 32 * kt2 * RSK, RSK, qf, s, r, h);
        bf16x8 pf[2];
        if (it == 0) sb_half<true>(s, carry, pf, limit - 32 * kt2, h);
        else sb_half<false>(s, carry, pf, 32, h);
        pv_half<2>(Vc + slot * 128 + 32 * kt2 * RSV, RSV, pf, o, lane);
      }
      wdone = __all((carry < 1e-37f) || !rowvalid);
    }
    volatile int* fl = flags + 4 * (it & 1);
    if (lane == 0) fl[w] = wdone ? 1 : 0;
    if (it + 1 < niter) {
      commit(it + 1, smem + ((it + 1) & 1) * TILEB);
      if (it + 2 < niter) issue(it + 2);
    }
    __syncthreads();
    if (fl[0] && fl[1] && fl[2] && fl[3]) break;
  }
  if (active && rowvalid) {
#pragma unroll
    for (int dt = 0; dt < 2; ++dt)
#pragma unroll
      for (int i4 = 0; i4 < 4; ++i4) {
        const int d0 = 32 * dt + 8 * i4 + 4 * h;
        uint2 g = *(const uint2*)(p.sgb() + (size_t)tok * 1024 + head * 64 + d0);
        st_bf4(p.A2() + (size_t)tok * 1024 + head * 64 + d0, o[dt][4 * i4] * bflo(g.x), o[dt][4 * i4 + 1] * bfhi(g.x),
               o[dt][4 * i4 + 2] * bflo(g.y), o[dt][4 * i4 + 3] * bfhi(g.y));
      }
  }
}

struct TileSched { int t, hi, step; };
DI TileSched tile_sched(int ntot) {
  TileSched ts;
  if ((gridDim.x & 7) == 0) {
    const int xcd = blockIdx.x & 7, j = blockIdx.x >> 3, nb = gridDim.x >> 3;
    ts.t = (int)(((long)ntot * xcd) >> 3) + j; ts.hi = (int)(((long)ntot * (xcd + 1)) >> 3); ts.step = nb;
  } else { ts.t = blockIdx.x; ts.hi = ntot; ts.step = gridDim.x; }
  return ts;
}
DI int next_item_xcd(unsigned* heads, int myx, int per, char* smem) {
  volatile int* slot = (volatile int*)(smem + SMEM_MAIN + 48);
  __syncthreads();
  if (threadIdx.x == 0) {
    int item = -1;
    for (int k = 0; k < 8; ++k) {
      const int q = (myx + k) & 7;
      const unsigned v = atomicAdd(heads + 64 * q, 1u);
      if (v < (unsigned)per) { item = q * per + (int)v; break; }
    }
    *slot = item;
  }
  __syncthreads();
  return *slot;
}
DI int next_item(unsigned* ctr, char* smem) {
  volatile int* slot = (volatile int*)(smem + SMEM_MAIN + 48);
  __syncthreads();
  if (threadIdx.x == 0) *slot = (int)atomicAdd(ctr, 1u);
  __syncthreads();
  return *slot;
}

__global__ void __launch_bounds__(256, 2) fwd_megakernel(Params p) {
  __shared__ __attribute__((aligned(16))) char smem[SMEM_TOTAL];
  const int tid = threadIdx.x;
  volatile LAS unsigned* st = (volatile LAS unsigned*)(smem + SMEM_MAIN + 32);
  if (tid < 16) ((volatile int*)(smem + SMEM_MAIN))[tid] = 0;
  __syncthreads();
  XcdBarrier xb = xcd_barrier_post(p.bar(), st);
  if (p.use_cg) cg::this_grid().sync();

  phase_p0(p, smem);
  xcd_barrier(xb);
  for (TileSched ts = tile_sched(128 * 12); ts.t < ts.hi; ts.t += ts.step) {
    const int mt = ts.t / 12, n2 = ts.t % 12;
    gemm_tile_wide<1024>(p.xb(), 1024, p.Wt_in_e(), 1024, mt * 128, n2 * 256, smem, [&](int half) { epi_e1a(p, mt, 2 * n2 + half, (const float*)smem); });
  }
  for (TileSched ts = tile_sched(8 * 24); ts.t < ts.hi; ts.t += ts.step) {
    const int hm = ts.t / 24, nt = ts.t % 24;
    gemm_tile<1024, 64>(p.xb(), 1024, p.Wt_in_e(), 1024, TP + hm * 64, nt * 128, smem);
    epi_e1a(p, 128 + (hm >> 1), nt, (const float*)smem, (hm & 1) * 64, 8);
  }
  xcd_barrier(xb);
  for (TileSched ts = tile_sched(MT * 10); ts.t < ts.hi; ts.t += ts.step) {
    const int t = ts.t;
    const int mt = t / 10, nt = t % 10;
    gemm_tile<256>(p.qlat(), 256, p.Wc(), 256, mt * 128, nt * 128, smem);
    epi_e1b(p, mt, nt, (const float*)smem);
  }
  xcd_barrier(xb);
  for (int rep = 0; rep < (REP == 2 ? 2 : 1); ++rep)
  for (;;) {
    const int item = next_item_xcd(p.bar() + (rep ? XB_XQ2(0) : XB_XQ(0)), (int)(xb.x & 7u), 276, smem);
    if (item < 0) break;
    const int q = item / 276, v = item % 276;
    if (v < 4) run_mla<true>(p, 4 * q + v, 0, 0, smem);
    else if (v < 20) { const int idx = 16 * q + (v - 4); run_diff<true>(p, idx >> 2, 0, idx & 3, smem); }
    else {
      const int j = v - 20, qb = 63 - (j >> 2), k = j & 3;
      if (k < 2) run_mla<false>(p, q >> 1, qb, 2 * (q & 1) + k, smem);
      else { const int pr = 2 * q + (k - 2); run_diff<false>(p, pr >> 2, qb, pr & 3, smem); }
    }
  }
  xcd_barrier(xb);
  for (TileSched ts = tile_sched(128 * 4); ts.t < ts.hi; ts.t += ts.step) {
    const int mt = ts.t >> 2, n2 = ts.t & 3;
    gemm_tile_wide<1024>(p.A2(), 1024, p.Wt_out_e(), 1024, mt * 128, n2 * 256, smem, [&](int half) { epi_out(p, mt, 2 * n2 + half, (const float*)smem, 0); });
  }
  for (TileSched ts = tile_sched(64); ts.t < ts.hi; ts.t += ts.step) {
    const int hm = ts.t >> 3, nt = ts.t & 7;
    gemm_tile<1024, 64>(p.A2(), 1024, p.Wt_out_e(), 1024, TP + hm * 64, nt * 128, smem);
    epi_out(p, 128 + (hm >> 1), nt, (const float*)smem, 0, (hm & 1) * 64, 8);
  }
  xcd_barrier(xb);
  phase_ln(p, 0);
  xcd_barrier(xb);
  for (TileSched ts = tile_sched(128 * 16); ts.t < ts.hi; ts.t += ts.step) {
    const int mt = ts.t >> 4, n2 = ts.t & 15;
    gemm_tile_wide<1024>(p.y0b(), 1024, p.Wt_in_o(), 1024, mt * 128, n2 * 256, smem, [&](int half) { epi_o1(p, mt, 2 * n2 + half, (const float*)smem); });
  }
  for (TileSched ts = tile_sched(8 * 32); ts.t < ts.hi; ts.t += ts.step) {
    const int hm = ts.t >> 5, nt = ts.t & 31;
    gemm_tile<1024, 64>(p.y0b(), 1024, p.Wt_in_o(), 1024, TP + hm * 64, nt * 128, smem);
    epi_o1(p, 128 + (hm >> 1), nt, (const float*)smem, (hm & 1) * 64, 8);
  }
  xcd_barrier(xb);
  for (int rep = 0; rep < (REP == 3 ? 2 : 1); ++rep)
  for (;;) {
    const int item = next_item(p.bar() + (rep ? XB_CTR3 : XB_CTR1), smem);
    if (item >= 2304) break;
    if (item >= 2048) { const int j = item - 2048; run_sb<true>(p, j >> 3, 0, j & 7, smem); }
    else { const int j = item; run_sb<false>(p, (j >> 3) & 3, 63 - (j >> 5), j & 7, smem); }
  }
  xcd_barrier(xb);
  for (TileSched ts = tile_sched(128 * 4); ts.t < ts.hi; ts.t += ts.step) {
    const int mt = ts.t >> 2, n2 = ts.t & 3;
    gemm_tile_wide<1024>(p.A2(), 1024, p.Wt_out_o(), 1024, mt * 128, n2 * 256, smem, [&](int half) { epi_out(p, mt, 2 * n2 + half, (const float*)smem, 1); });
  }
  for (TileSched ts = tile_sched(64); ts.t < ts.hi; ts.t += ts.step) {
    const int hm = ts.t >> 3, nt = ts.t & 7;
    gemm_tile<1024, 64>(p.A2(), 1024, p.Wt_out_o(), 1024, TP + hm * 64, nt * 128, smem);
    epi_out(p, 128 + (hm >> 1), nt, (const float*)smem, 1, (hm & 1) * 64, 8);
  }
  xcd_barrier(xb);
  phase_ln(p, 1);
}

extern "C" void kernel_launch(void* const* d_in, const int* in_sizes, int n_in, void* d_out, int out_size, void* d_ws, size_t ws_size,
                              hipStream_t stream) {
  static int grid_blocks = 0;
  if (!grid_blocks) {
    int dev = 0, cus = 0, per_cu = 0;
    (void)hipGetDevice(&dev);
    (void)hipDeviceGetAttribute(&cus, hipDeviceAttributeMultiprocessorCount, dev);
    (void)hipOccupancyMaxActiveBlocksPerMultiprocessor(&per_cu, fwd_megakernel, 256, 0);
    if (per_cu > 2) per_cu = 2;
    if (per_cu < 1) per_cu = 1;
    grid_blocks = cus * per_cu;
  }
  Params p;
  memset(&p, 0, sizeof(p));
  const float* const* in = (const float* const*)d_in;
  p.x_prompt = in[0]; p.x_sample = in[1]; p.c_ckv = in[2]; p.c_krope = in[3]; p.c_dk = in[4]; p.c_dv = in[5]; p.c_sk = in[6]; p.c_sv = in[7];
  p.w_in_even = in[8]; p.q_g = in[9]; p.w_uq = in[10]; p.kv_g = in[11]; p.w_uk = in[12]; p.w_uv = in[13]; p.lam_q = in[14]; p.lam_k = in[15];
  p.subln_g = in[16]; p.w_out_even = in[17]; p.ln_e_g = in[18]; p.ln_e_b = in[19]; p.w_in_odd = in[20]; p.w_out_odd = in[21]; p.ln_o_g = in[22]; p.ln_o_b = in[23];
  p.out = (float*)d_out;
  p.ws = (char*)d_ws;
  const size_t off = WS_END;
  p.use_cg = 0;
  if (off > ws_size) { fprintf(stderr, "workspace too small: need %zu have %zu\n", off, ws_size); return; }
  (void)hipMemsetAsync(d_ws, 0, BAR_BYTES, stream);
  void* args[] = {&p};
  hipError_t e = hipLaunchCooperativeKernel((void*)fwd_megakernel, dim3(grid_blocks), dim3(256), args, 0, stream);
  if (e != hipSuccess) fprintf(stderr, "cooperative launch failed: %s (grid %d)\n", hipGetErrorString(e), grid_blocks);
}
```
